# Optimizing an MI355X kernel written in HIP

```python
import math
import jax, jax.numpy as jnp
from jax import lax
import numpy as np

D_MODEL = 2048
BATCH = 4
SEQ = 8192
DEPTH = 1
DEC_BATCH = 2
DEC_SEQ = 4096
PAST_LEN = 128

N_MEM = 256
DIL_PAIRS = ((128, 1), (512, 4), (2048, 16))
N_DIL = 3
A_HEADS = 4
A_HD = 128
A_WIDTH = A_HEADS * A_HD
B_HEADS = 8
Q_LORA = 512
KV_LORA = 512
D_NOPE = 128
D_ROPE = 64
D_V = 128
B_WIDTH = B_HEADS * D_V
ROPE_BASE = 10000.0
Q_BLOCK = 128
C_HEADS = 4
C_HD = 128
C_WIDTH = C_HEADS * C_HD
D_MIX = A_WIDTH + B_WIDTH + C_WIDTH
N_BUCKETS = 32
MAX_DISTANCE = 1024
EPS = 1e-6
NEG = -1e30
IN_SIZES = (N_DIL * A_WIDTH, A_WIDTH, A_WIDTH, A_WIDTH,
            Q_LORA, KV_LORA, D_ROPE, B_WIDTH,
            C_WIDTH, C_WIDTH)
D_IN = sum(IN_SIZES)

kernel_name = 'hybrid_dilated_mla_memory_encoder'


def rmsnorm(x, g):
    xf = x.astype(jnp.float32)
    y = xf * lax.rsqrt(jnp.mean(xf * xf, axis=-1, keepdims=True) + EPS)
    return (y * g.astype(jnp.float32)).astype(x.dtype)


def t5_bucket(rel):
    nb = N_BUCKETS // 2
    max_exact = nb // 2
    bucket = jnp.where(rel > 0, nb, 0)
    n = jnp.abs(rel)
    nf = jnp.maximum(n, 1).astype(jnp.float32)
    large = max_exact + (jnp.log(nf / max_exact) / math.log(MAX_DISTANCE / max_exact)
                         * (nb - max_exact)).astype(jnp.int32)
    large = jnp.minimum(large, nb - 1)
    return bucket + jnp.where(n < max_exact, n, large)


def dilated_attention(q, k, v, bias_table, window, dil):
    Bn, S, H, E = q.shape
    blk = window // (2 * dil)
    L = S // dil
    nb = -(-L // blk)
    Lp = nb * blk

    def to_res(t):
        return t.reshape(Bn, L, dil, H, E).transpose(0, 2, 1, 3, 4)

    qr = jnp.pad(to_res(q), ((0, 0), (0, 0), (0, Lp - L), (0, 0), (0, 0))).reshape(Bn, dil, nb, blk, H, E)

    def windows(t):
        tp = jnp.pad(to_res(t), ((0, 0), (0, 0), (blk, Lp - L + blk), (0, 0), (0, 0)))
        tp = tp.reshape(Bn, dil, nb + 2, blk, H, E)
        return jnp.concatenate([tp[:, :, 0:nb], tp[:, :, 1:nb + 1], tp[:, :, 2:nb + 2]], axis=3)

    kw, vw = windows(k), windows(v)
    qi = jnp.arange(blk)[:, None]
    kj = jnp.arange(3 * blk)[None, :]
    rel = kj - blk - qi
    bias = bias_table.astype(jnp.float32)[t5_bucket(rel * dil)].transpose(2, 0, 1)
    key_l = jnp.arange(nb)[:, None] * blk - blk + kj
    valid = (jnp.abs(rel)[None] <= blk) & ((key_l >= 0) & (key_l < L))[:, None, :]
    s = jnp.einsum('bdnqhe,bdnkhe->bdnhqk', qr, kw, preferred_element_type=jnp.float32) * (E ** -0.5)
    s = jnp.where(valid[None, None, :, None], s + bias[None, None, None], NEG)
    m = jnp.max(s, axis=-1, keepdims=True)
    p = jnp.exp(s - m)
    den = jnp.sum(p, axis=-1, keepdims=True)
    o = jnp.einsum('bdnhqk,bdnkhe->bdnqhe', (p / den).astype(v.dtype), vw)
    lse = (m + jnp.log(den))[..., 0].swapaxes(3, 4)

    def from_res(t):
        t = t.reshape(Bn, dil, Lp, *t.shape[4:])[:, :, :L]
        return t.swapaxes(1, 2).reshape(Bn, S, *t.shape[3:])

    return from_res(o), from_res(lse)


def apply_rope(t):
    S = t.shape[1]
    inv = ROPE_BASE ** (-jnp.arange(0, D_ROPE, 2, dtype=jnp.float32) / D_ROPE)
    ang = jnp.arange(S, dtype=jnp.float32)[:, None] * inv[None, :]
    shape = (1, S) + (1,) * (t.ndim - 3) + (D_ROPE // 2,)
    cos, sin = jnp.cos(ang).reshape(shape), jnp.sin(ang).reshape(shape)
    tf = t.astype(jnp.float32)
    t1, t2 = tf[..., :D_ROPE // 2], tf[..., D_ROPE // 2:]
    return jnp.concatenate([t1 * cos - t2 * sin, t1 * sin + t2 * cos], axis=-1).astype(t.dtype)


def mla_attention(q_nope, q_rope, k_nope, k_rope, v):
    Bn, S, H, _ = q_nope.shape
    nq = S // Q_BLOCK
    scale = (D_NOPE + D_ROPE) ** -0.5

    def blocks(t):
        return t.reshape(Bn, nq, Q_BLOCK, *t.shape[2:]).swapaxes(0, 1)

    def one_block(args):
        qn, qr = args
        s = (jnp.einsum('bqhe,bkhe->bhqk', qn, k_nope, preferred_element_type=jnp.float32)
             + jnp.einsum('bqhe,bke->bhqk', qr, k_rope, preferred_element_type=jnp.float32)) * scale
        p = jax.nn.softmax(s, axis=-1)
        return jnp.einsum('bhqk,bkhe->bqhe', p.astype(v.dtype), v)

    o = lax.map(one_block, (blocks(q_nope), blocks(q_rope)))
    return o.swapaxes(0, 1).reshape(Bn, S, H, D_V)


def memory_attention(q, mem, mem_gain, w_mem_kv):
    Bn, S = q.shape[:2]
    M = mem.shape[1]
    mkv = (rmsnorm(mem, mem_gain) @ w_mem_kv).reshape(Bn, M, 2, C_HEADS, C_HD)
    mk, mv = mkv[:, :, 0], mkv[:, :, 1]
    s = jnp.einsum('bshe,bmhe->bhsm', q, mk, preferred_element_type=jnp.float32) * (C_HD ** -0.5)
    p = jax.nn.softmax(s, axis=-1)
    return jnp.einsum('bhsm,bmhe->bshe', p.astype(mv.dtype), mv).reshape(Bn, S, C_WIDTH)


def hybrid_layer(x, mem, pre_gain, w_in, q_gain, w_uq, kv_gain, w_ukv, mem_gain, w_mem_kv,
                 w_out, post_gain, rel_bias):
    Bn, S, _ = x.shape
    h = rmsnorm(x, pre_gain)
    offsets = [int(v) for v in np.cumsum(IN_SIZES)[:-1]]
    a_q, a_k, a_v, a_g, b_cq, b_ckv, b_kr, b_g, c_q, c_g = jnp.split(h @ w_in, offsets, axis=-1)

    qa = a_q.reshape(Bn, S, N_DIL, A_HEADS, A_HD)
    ka = a_k.reshape(Bn, S, A_HEADS, A_HD)
    va = a_v.reshape(Bn, S, A_HEADS, A_HD)
    outs, lses = [], []
    for g, (win, dil) in enumerate(DIL_PAIRS):
        o, l = dilated_attention(qa[:, :, g], ka, va, rel_bias[:, g * A_HEADS:(g + 1) * A_HEADS], win, dil)
        outs.append(o)
        lses.append(l)
    alpha = jax.nn.softmax(jnp.stack(lses, axis=0), axis=0)
    oa = jnp.einsum('gbsh,gbshe->bshe', alpha, jnp.stack(outs, axis=0).astype(jnp.float32))
    ya = oa.reshape(Bn, S, A_WIDTH).astype(x.dtype) * jax.nn.silu(a_g)

    qb = (rmsnorm(b_cq, q_gain) @ w_uq).reshape(Bn, S, B_HEADS, D_NOPE + D_ROPE)
    q_nope, q_rope = qb[..., :D_NOPE], apply_rope(qb[..., D_NOPE:])
    kvb = (rmsnorm(b_ckv, kv_gain) @ w_ukv).reshape(Bn, S, B_HEADS, D_NOPE + D_V)
    k_nope, vb = kvb[..., :D_NOPE], kvb[..., D_NOPE:]
    k_rope = apply_rope(b_kr)
    yb = mla_attention(q_nope, q_rope, k_nope, k_rope, vb).reshape(Bn, S, B_WIDTH) * jax.nn.silu(b_g)

    yc = memory_attention(c_q.reshape(Bn, S, C_HEADS, C_HD), mem, mem_gain, w_mem_kv) * jax.nn.silu(c_g)

    y = jnp.concatenate([ya, yb, yc], axis=-1) @ w_out
    return x + rmsnorm(y, post_gain)


def setup_inputs(seed: int = 0) -> dict:
    key = jax.random.key(seed)
    ks = jax.random.split(key, 16)

    def w(k, shape, fan_in):
        return jax.random.normal(k, shape, jnp.float32) * (fan_in ** -0.5)

    def gain(k, dim):
        return 1.0 + 0.01 * jax.random.normal(k, (DEPTH, dim), jnp.float32)

    return {
        'x_prompt': jax.random.normal(ks[0], (BATCH, SEQ, D_MODEL), jnp.float32),
        'x_sample': jax.random.normal(ks[1], (DEC_BATCH, DEC_SEQ, D_MODEL), jnp.float32),
        'mem_prompt': jax.random.normal(ks[2], (BATCH, N_MEM, D_MODEL), jnp.float32),
        'mem_sample': jax.random.normal(ks[3], (DEC_BATCH, N_MEM, D_MODEL), jnp.float32),
        'pre_gain': gain(ks[4], D_MODEL),
        'w_in': w(ks[5], (DEPTH, D_MODEL, D_IN), D_MODEL),
        'q_gain': gain(ks[6], Q_LORA),
        'w_uq': w(ks[7], (DEPTH, Q_LORA, B_HEADS * (D_NOPE + D_ROPE)), Q_LORA),
        'kv_gain': gain(ks[8], KV_LORA),
        'w_ukv': w(ks[9], (DEPTH, KV_LORA, B_HEADS * (D_NOPE + D_V)), KV_LORA),
        'mem_gain': gain(ks[10], D_MODEL),
        'w_mem_kv': w(ks[11], (DEPTH, D_MODEL, 2 * C_WIDTH), D_MODEL),
        'w_out': w(ks[12], (DEPTH, D_MIX, D_MODEL), D_MIX),
        'post_gain': gain(ks[13], D_MODEL),
        'rel_bias': 0.5 * jax.random.normal(ks[14], (N_BUCKETS, N_DIL * A_HEADS), jnp.float32),
    }


def reference(x_prompt, x_sample, mem_prompt, mem_sample, pre_gain, w_in, q_gain, w_uq, kv_gain, w_ukv,
              mem_gain, w_mem_kv, w_out, post_gain, rel_bias):
    def trunk(x, mem):
        for l in range(DEPTH):
            x = hybrid_layer(x, mem, pre_gain[l], w_in[l], q_gain[l], w_uq[l], kv_gain[l], w_ukv[l],
                             mem_gain[l], w_mem_kv[l], w_out[l], post_gain[l], rel_bias)
        return x

    y_prompt = trunk(x_prompt, mem_prompt)
    y_sample = trunk(x_sample, mem_sample)
    return (y_prompt, y_sample)
```

```cpp
#include <hip/hip_runtime.h>
#include <hip/hip_cooperative_groups.h>
#include <cstdio>
#include <cstdint>
namespace cg = cooperative_groups;

#ifndef MK_SINGLE
#define MK_SINGLE 1
#endif
#ifndef PHM
#define PHM 63
#endif
#define DBG 0

#define LAS __attribute__((address_space(3)))
#define OPAQUE(x) asm volatile("" : "+v"(x))
#define MEMFENCE() asm volatile("" ::: "memory")
typedef unsigned short bf16_t;
typedef short bf16x8 __attribute__((ext_vector_type(8)));
typedef short s16x4 __attribute__((ext_vector_type(4)));
typedef float f32x4 __attribute__((ext_vector_type(4)));
typedef float f32x16 __attribute__((ext_vector_type(16)));
typedef unsigned u32x4 __attribute__((ext_vector_type(4)));
typedef unsigned u32x2 __attribute__((ext_vector_type(2)));

constexpr int NTOK = 40960, NPROMPT = 32768, DMODEL = 2048;
constexpr int NP = 6144;
constexpr int N1 = 6400;
constexpr int PC_AQ = 0, PC_AK = 1536, PC_AV = 2048, PC_AG = 2560, PC_BCQ = 3072, PC_BCKV = 3584, PC_BG = 4096, PC_CQ = 5120, PC_CG = 5632;
constexpr float LOG2E = 1.4426950408889634f;
constexpr float QS128 = 0.08838834764831845f * LOG2E;
constexpr float QS192 = 0.07216878364870323f * LOG2E;
constexpr float EPS = 1e-6f;

constexpr size_t MiB = 1u << 20;
constexpr size_t WS_SSQ_Q = 0, WS_SSQ_KV = 163840, WS_SSQ_Y = 327680, WS_CTL_BYTES = 491520;
constexpr size_t WS_BAR = 655360;
constexpr size_t WS_ROPE = 1 * MiB;
constexpr size_t WS_WIN = 4 * MiB;
constexpr size_t WS_WUQ = 29 * MiB;
constexpr size_t WS_WUKV = 31 * MiB;
constexpr size_t WS_WOUT = 33 * MiB;
constexpr size_t WS_WMEM = 41 * MiB;
constexpr size_t WS_MEMN = 45 * MiB;
constexpr size_t WS_MKV = 51 * MiB;
constexpr size_t WS_KR = 54 * MiB;
constexpr size_t WS_H = 60 * MiB;
constexpr size_t WS_P = 220 * MiB;
constexpr size_t WS_QB = 700 * MiB;
constexpr size_t WS_KVB = 820 * MiB;
constexpr size_t WS_LSE = 980 * MiB;
constexpr size_t WS_END = 982 * MiB;

constexpr int LDS_BYTES = 147456;

typedef float f32x2_t __attribute__((ext_vector_type(2))); typedef __bf16 bf16x2_t __attribute__((ext_vector_type(2)));
__device__ __forceinline__ unsigned cvt_pk_bf16(float lo, float hi) { f32x2_t v = {lo, hi}; bf16x2_t b = __builtin_convertvector(v, bf16x2_t); return __builtin_bit_cast(unsigned, b); }
__device__ __forceinline__ unsigned f2bf(float f) { unsigned u = __builtin_bit_cast(unsigned, f); return (u + 0x7fffu + ((u >> 16) & 1u)) >> 16; }
__device__ __forceinline__ unsigned pk2(float lo, float hi) { return f2bf(lo) | (f2bf(hi) << 16); }
__device__ __forceinline__ float bf_lo(unsigned w) { return __builtin_bit_cast(float, w << 16); }
__device__ __forceinline__ float bf_hi(unsigned w) { return __builtin_bit_cast(float, w & 0xffff0000u); }
__device__ __forceinline__ float wave_sum(float v) {
#pragma unroll
    for (int o = 1; o < 64; o <<= 1) v += __shfl_xor(v, o);
    return v;
}
__device__ __forceinline__ float xhalf_max(float v) { auto rr = __builtin_amdgcn_permlane32_swap(__float_as_uint(v), __float_as_uint(v), false, false); return fmaxf(__uint_as_float(rr[0]), __uint_as_float(rr[1])); }
__device__ __forceinline__ float xhalf_sum(float v) { auto rr = __builtin_amdgcn_permlane32_swap(__float_as_uint(v), __float_as_uint(v), false, false); return __uint_as_float(rr[0]) + __uint_as_float(rr[1]); }
__device__ __forceinline__ int row_pos(int row) { return row < NPROMPT ? (row & 8191) : (row & 4095); }
__device__ __forceinline__ float silu(float x) { return x / (1.f + __expf(-x)); }

namespace pg8 {
constexpr int BM = 256, BK = 64, HALF = 128, HTB = HALF * BK * 2, STAGE_BYTES = 8 * HTB, NXCD = 8, WGM = 8;
__host__ __device__ __forceinline__ int lds_byte(int r, int c) { const int st = (r >> 4) * 2 + (c >> 5), rr = r & 15, cc = c & 31, ob = rr * 64 + cc * 2; return st * 1024 + (ob ^ (((ob >> 9) & 1) << 5)); }
__host__ __device__ __forceinline__ void stage_rc(int b, int& R, int& C) { const int st = b / 1024, sb = b % 1024, swz = sb ^ (((sb >> 9) & 1) << 5); R = (st >> 1) * 16 + swz / 64; C = (st & 1) * 32 + (swz % 64) / 2; }
__host__ __device__ __forceinline__ int perm32(int rho) { const int n = rho >> 4, i = rho & 15; return 8 * (i >> 2) + 4 * n + (i & 3); }

struct Unit { int pm, pn; };
struct Gemm { const bf16_t* A; const bf16_t* Bt; int lda, M, N, K; };

struct StaticOrder {
    int nM, nN, nwg, G, c;
    __device__ void init(int M, int N, int G_, int c_) { nM = M / BM; nN = N / BM; nwg = nM * nN; G = G_; c = c_; }
    __device__ bool next(int i, Unit& u) const {
        const long L = (long)i * G + c; if (L >= nwg) return false;
        int wgid = (int)L; { const int q = nwg / NXCD, r = nwg % NXCD, xcd = wgid % NXCD, off = wgid / NXCD; wgid = (xcd < r ? xcd * (q + 1) : r * (q + 1) + (xcd - r) * q) + off; }
        const int nig = WGM * nN, gid = wgid / nig, fm = gid * WGM, gsz = (nM - fm) < WGM ? (nM - fm) : WGM;
        u.pm = fm + ((wgid % nig) % gsz); u.pn = (wgid % nig) / gsz; return true;
    }
};

template <class Epi, class Sched>
__device__ __forceinline__ void gemm_phase(LAS unsigned char* lds, const Gemm g, const Sched& S, const Epi& E) {
    int tid = threadIdx.x; OPAQUE(tid);
    const int wid = __builtin_amdgcn_readfirstlane(tid >> 6), lane = tid & 63, wr = wid >> 2, wc = wid & 3, fr = lane & 15, fq = lane >> 4;
    const int K = g.K, nt = K / BK, lda = g.lda;
    unsigned voffA[2], voffB[2];
#pragma unroll
    for (int i = 0; i < 2; ++i) { int R, C; stage_rc(tid * 16 + i * 8192, R, C); const int Rb = Epi::PERM ? (R & ~31) + perm32(R & 31) : R;
        voffA[i] = (unsigned)(R * lda + C) * 2u; voffB[i] = (unsigned)(Rb * K + C) * 2u; }
    const size_t kstep = (size_t)(BK * 2);
    const size_t hstepA = (size_t)HALF * lda * 2, hstepB = (size_t)HALF * K * 2;
    const size_t tstepA = 2 * hstepA, tstepB = 2 * hstepB;
    const unsigned ldsw = (unsigned)wid * 1024u;
    const int aoff = lds_byte(wr * 64 + fr, fq * 8), boff = lds_byte(wc * 32 + fr, fq * 8);
#define PG8_SA(b, h) (((b) * 2 + (h)) * HTB)
#define PG8_SB(b, h) ((4 + (b) * 2 + (h)) * HTB)
#define PG8_STAGE(bufoff, gbase, voff) do { _Pragma("unroll") for (int _i = 0; _i < 2; ++_i) \
        __builtin_amdgcn_global_load_lds((const unsigned*)((const char*)(gbase) + (voff)[_i]), (LAS unsigned*)(lds + (bufoff) + ldsw + _i * 8192), 16, 0, 0); } while (0)
#define PG8_LDA(dst, b, h) do { _Pragma("unroll") for (int m = 0; m < 4; ++m) _Pragma("unroll") for (int k = 0; k < 2; ++k) dst[m][k] = *(const LAS bf16x8*)(lds + PG8_SA(b, h) + aoff + m * 2048 + k * 1024); } while (0)
#define PG8_LDB(dst, b, h) do { _Pragma("unroll") for (int n = 0; n < 2; ++n) _Pragma("unroll") for (int k = 0; k < 2; ++k) dst[n][k] = *(const LAS bf16x8*)(lds + PG8_SB(b, h) + boff + n * 2048 + k * 1024); } while (0)
#define PG8_MMA(ai, bj, At, Bt) do { __builtin_amdgcn_s_setprio(1); _Pragma("unroll") for (int m = 0; m < 4; ++m) _Pragma("unroll") for (int n = 0; n < 2; ++n) _Pragma("unroll") for (int k = 0; k < 2; ++k) \
        acc[ai][bj][m][n] = __builtin_amdgcn_mfma_f32_16x16x32_bf16(Bt[n][k], At[m][k], acc[ai][bj][m][n], 0, 0, 0); __builtin_amdgcn_s_setprio(0); } while (0)
#define PG8_WAIT_V(n) asm volatile("s_waitcnt vmcnt(" #n ")" ::: "memory")
#define PG8_WAIT_L(n) asm volatile("s_waitcnt lgkmcnt(" #n ")" ::: "memory")
#define PG8_BAR __builtin_amdgcn_s_barrier()
#define PG8_SCHED __builtin_amdgcn_sched_barrier(0)
    Unit cur, nxt; int ui = 0;
    if (!S.next(0, cur)) return;
    f32x4 acc[2][2][4][2];
#pragma unroll
    for (int a = 0; a < 2; ++a)
#pragma unroll
        for (int b = 0; b < 2; ++b)
#pragma unroll
            for (int m = 0; m < 4; ++m)
#pragma unroll
                for (int n = 0; n < 2; ++n) acc[a][b][m][n] = (f32x4){0.f, 0.f, 0.f, 0.f};
    bf16x8 At[4][2], B0[2][2], B1[2][2];
    const char* cA = (const char*)g.A + (size_t)cur.pm * tstepA; const char* cB = (const char*)g.Bt + (size_t)cur.pn * tstepB;
    PG8_STAGE(PG8_SB(0, 0), cB, voffB); PG8_STAGE(PG8_SB(0, 1), cB + hstepB, voffB); PG8_STAGE(PG8_SA(0, 0), cA, voffA); PG8_STAGE(PG8_SA(0, 1), cA + hstepA, voffA);
    if (wr == 1) PG8_BAR;
    PG8_WAIT_V(2); PG8_BAR;
    PG8_STAGE(PG8_SB(1, 0), cB + kstep, voffB); PG8_STAGE(PG8_SA(1, 0), cA + kstep, voffA); PG8_STAGE(PG8_SB(1, 1), cB + hstepB + kstep, voffB);
    PG8_WAIT_V(6); PG8_BAR;
    for (;;) {
        const bool has_next = S.next(ui + 1, nxt);
        const char* nA = has_next ? (const char*)g.A + (size_t)nxt.pm * tstepA : cA; const char* nB = has_next ? (const char*)g.Bt + (size_t)nxt.pn * tstepB : cB;
        for (int t = 0; t < nt; t += 2) {
            const bool last = (t == nt - 2);
            const char* a1 = cA + (size_t)(t + 1) * kstep;
            const char* a2 = last ? nA : cA + (size_t)(t + 2) * kstep; const char* b2 = last ? nB : cB + (size_t)(t + 2) * kstep;
            const char* a3 = a2 + kstep; const char* b3 = b2 + kstep;
            PG8_LDB(B0, 0, 0); PG8_LDB(B1, 0, 1); PG8_SCHED; PG8_LDA(At, 0, 0); PG8_STAGE(PG8_SA(1, 1), a1 + hstepA, voffA);
            PG8_WAIT_V(8); PG8_WAIT_L(0); PG8_BAR; PG8_MMA(0, 0, At, B0); PG8_MMA(0, 1, At, B1); PG8_BAR; PG8_SCHED;
            PG8_LDA(At, 0, 1); PG8_STAGE(PG8_SB(0, 0), b2, voffB); PG8_STAGE(PG8_SB(0, 1), b2 + hstepB, voffB); PG8_STAGE(PG8_SA(0, 0), a2, voffA);
            PG8_WAIT_V(8); PG8_WAIT_L(0); PG8_BAR; PG8_MMA(1, 0, At, B0); PG8_MMA(1, 1, At, B1); PG8_BAR; PG8_SCHED;
            PG8_LDB(B0, 1, 0); PG8_LDB(B1, 1, 1); PG8_SCHED; PG8_LDA(At, 1, 0); PG8_STAGE(PG8_SA(0, 1), a2 + hstepA, voffA);
            PG8_WAIT_V(8); PG8_WAIT_L(0); PG8_BAR; PG8_MMA(0, 0, At, B0); PG8_MMA(0, 1, At, B1); PG8_BAR; PG8_SCHED;
            PG8_LDA(At, 1, 1); PG8_STAGE(PG8_SB(1, 0), b3, voffB); PG8_STAGE(PG8_SB(1, 1), b3 + hstepB, voffB); PG8_STAGE(PG8_SA(1, 0), a3, voffA);
            PG8_WAIT_V(8); PG8_WAIT_L(0); PG8_BAR; PG8_MMA(1, 0, At, B0); PG8_MMA(1, 1, At, B1); PG8_BAR; PG8_SCHED;
        }
        if (wr == 0) PG8_BAR;
        E(acc, cur, wr, wc, fr, fq);
        if (!has_next) break;
#pragma unroll
        for (int a = 0; a < 2; ++a)
#pragma unroll
            for (int b = 0; b < 2; ++b)
#pragma unroll
                for (int m = 0; m < 4; ++m)
#pragma unroll
                    for (int n = 0; n < 2; ++n) acc[a][b][m][n] = (f32x4){0.f, 0.f, 0.f, 0.f};
        cur = nxt; cA = nA; cB = nB; ++ui;
        if (wr == 1) PG8_BAR;
    }
    PG8_WAIT_V(0);
    PG8_BAR;
#undef PG8_SA
#undef PG8_SB
#undef PG8_STAGE
#undef PG8_LDA
#undef PG8_LDB
#undef PG8_MMA
#undef PG8_WAIT_V
#undef PG8_WAIT_L
#undef PG8_BAR
#undef PG8_SCHED
}
}

typedef const f32x4 (&AccRef)[2][2][4][2];
__device__ __forceinline__ u32x4 pack8(f32x4 v0, f32x4 v1) { u32x4 w; w.x = cvt_pk_bf16(v0[0], v0[1]); w.y = cvt_pk_bf16(v0[2], v0[3]); w.z = cvt_pk_bf16(v1[0], v1[1]); w.w = cvt_pk_bf16(v1[2], v1[3]); return w; }
__device__ __forceinline__ void rope8(f32x4& v0, f32x4& v1, f32x4 cs0, f32x4 cs1) {
    f32x4 a = v0, b = v1;
    v0[0] = a[0] * cs0[0] - a[1] * cs0[1]; v0[1] = a[0] * cs0[1] + a[1] * cs0[0];
    v0[2] = a[2] * cs0[2] - a[3] * cs0[3]; v0[3] = a[2] * cs0[3] + a[3] * cs0[2];
    v1[0] = b[0] * cs1[0] - b[1] * cs1[1]; v1[1] = b[0] * cs1[1] + b[1] * cs1[0];
    v1[2] = b[2] * cs1[2] - b[3] * cs1[3]; v1[3] = b[2] * cs1[3] + b[3] * cs1[2];
}

__device__ __forceinline__ float sq8(f32x4 v0, f32x4 v1) { return (v0[0] * v0[0] + v0[1] * v0[1]) + (v0[2] * v0[2] + v0[3] * v0[3]) + (v1[0] * v1[0] + v1[1] * v1[1]) + (v1[2] * v1[2] + v1[3] * v1[3]); }
struct EpiP1 {
    static constexpr bool PERM = true;
    bf16_t* P; bf16_t* KR; float* ssq_q; float* ssq_kv; const float* rope;
    __device__ __forceinline__ void operator()(AccRef acc, const pg8::Unit& u, int wr, int wc, int fr, int fq) const {
        int row = u.pm * 256 + wr * 64 + fr;
        if (u.pn < 24) {
            unsigned off = ((unsigned)row * NP + (unsigned)(u.pn * 256 + wc * 32 + 8 * fq)) * 2u;
            float* ssq = (u.pn >= 12 && u.pn < 14) ? ssq_q : ((u.pn >= 14 && u.pn < 16) ? ssq_kv : nullptr);
#pragma unroll
            for (int ai = 0; ai < 2; ++ai) {
#pragma unroll
                for (int m = 0; m < 4; ++m) {
                    const f32x4 a0 = acc[ai][0][m][0], a1 = acc[ai][0][m][1], b0 = acc[ai][1][m][0], b1 = acc[ai][1][m][1];
                    __builtin_nontemporal_store(pack8(a0, a1), (u32x4*)((char*)P + off)); __builtin_nontemporal_store(pack8(b0, b1), (u32x4*)((char*)P + off + 256));
                    if (ssq) { float s = sq8(a0, a1) + sq8(b0, b1); s += __shfl_xor(s, 16); s += __shfl_xor(s, 32); if (fq == 0) atomicAdd(ssq + row, s); }
                    off += 16u * NP * 2u; row += 16; OPAQUE(off); OPAQUE(row); MEMFENCE();
                }
                off += 64u * NP * 2u; row += 64;
            }
        } else if (wc < 2) {
            unsigned off = ((unsigned)row * 64 + (unsigned)(wc * 32 + 8 * fq)) * 2u;
            const unsigned pmask = row < NPROMPT ? 8191u : 4095u;
#pragma unroll
            for (int ai = 0; ai < 2; ++ai) {
#pragma unroll
                for (int m = 0; m < 4; ++m) {
                    const unsigned pos = (unsigned)row & pmask;
                    const float* rp = rope + (pos * 32u + (unsigned)(wc * 16 + 4 * fq)) * 2u;
                    const f32x4 cs0 = *(const f32x4*)rp, cs1 = *(const f32x4*)(rp + 4);
                    f32x4 v0 = acc[ai][0][m][0], v1 = acc[ai][0][m][1];
                    rope8(v0, v1, cs0, cs1);
                    *(u32x4*)((char*)KR + off) = pack8(v0, v1);
                    off += 16u * 64 * 2u; row += 16; OPAQUE(off); OPAQUE(row); MEMFENCE();
                }
                off += 64u * 64 * 2u; row += 64;
            }
        }
    }
};
struct EpiQ {
    static constexpr bool PERM = true;
    bf16_t* QB; const float* ssq; const float* rope;
    __device__ __forceinline__ void operator()(AccRef acc, const pg8::Unit& u, int wr, int wc, int fr, int fq) const {
        int row = u.pm * 256 + wr * 64 + fr; const int colb = u.pn * 256 + wc * 32 + 8 * fq;
        const int cm0 = colb % 192, cm1 = (colb + 128) % 192;
        const unsigned pmask = row < NPROMPT ? 8191u : 4095u;
        unsigned off = ((unsigned)row * 1536 + (unsigned)colb) * 2u;
#pragma unroll
        for (int ai = 0; ai < 2; ++ai) {
#pragma unroll
            for (int m = 0; m < 4; ++m) {
                const unsigned pos = (unsigned)row & pmask;
                const float rinv = rsqrtf(ssq[row] * (1.f / 512.f) + EPS);
                f32x4 a0 = acc[ai][0][m][0] * rinv, a1 = acc[ai][0][m][1] * rinv, b0 = acc[ai][1][m][0] * rinv, b1 = acc[ai][1][m][1] * rinv;
                if (cm0 >= 128) { const float* rp = rope + (pos * 32u + (unsigned)((cm0 - 128) >> 1)) * 2u; rope8(a0, a1, *(const f32x4*)rp, *(const f32x4*)(rp + 4)); }
                if (cm1 >= 128) { const float* rp = rope + (pos * 32u + (unsigned)((cm1 - 128) >> 1)) * 2u; rope8(b0, b1, *(const f32x4*)rp, *(const f32x4*)(rp + 4)); }
                *(u32x4*)((char*)QB + off) = pack8(a0, a1); *(u32x4*)((char*)QB + off + 256) = pack8(b0, b1);
                off += 16u * 1536 * 2u; row += 16; OPAQUE(off); OPAQUE(row); MEMFENCE();
            }
            off += 64u * 1536 * 2u; row += 64;
        }
    }
};
struct EpiScale {
    static constexpr bool PERM = true;
    bf16_t* Ob; int ldc; const float* ssq; int headmajor;
    __device__ __forceinline__ void operator()(AccRef acc, const pg8::Unit& u, int wr, int wc, int fr, int fq) const {
        int row = u.pm * 256 + wr * 64 + fr; const int colb = (headmajor ? 0 : u.pn * 256) + wc * 32 + 8 * fq;
        bf16_t* O = Ob + (headmajor ? (size_t)u.pn * ((size_t)NTOK * 256) : (size_t)0);
        unsigned off = ((unsigned)row * (unsigned)ldc + (unsigned)colb) * 2u; const unsigned rstep = 16u * (unsigned)ldc * 2u;
#pragma unroll
        for (int ai = 0; ai < 2; ++ai) {
#pragma unroll
            for (int m = 0; m < 4; ++m) {
                const float rinv = ssq ? rsqrtf(ssq[row] * (1.f / 512.f) + EPS) : 1.f;
                *(u32x4*)((char*)O + off) = pack8(acc[ai][0][m][0] * rinv, acc[ai][0][m][1] * rinv);
                *(u32x4*)((char*)O + off + 256) = pack8(acc[ai][1][m][0] * rinv, acc[ai][1][m][1] * rinv);
                off += rstep; row += 16; OPAQUE(off); OPAQUE(row); MEMFENCE();
            }
            off += 4u * rstep; row += 64;
        }
    }
};
struct EpiY {
    static constexpr bool PERM = false;
    float* out; float* ssq;
    __device__ __forceinline__ void operator()(AccRef acc, const pg8::Unit& u, int wr, int wc, int fr, int fq) const {
        int row = u.pm * 256 + wr * 64 + fr; const int colb = u.pn * 256 + wc * 32 + 4 * fq;
        unsigned off = ((unsigned)row * DMODEL + (unsigned)colb) * 4u;
#pragma unroll
        for (int ai = 0; ai < 2; ++ai) {
#pragma unroll
            for (int m = 0; m < 4; ++m) {
                const f32x4 a0 = acc[ai][0][m][0], a1 = acc[ai][0][m][1], b0 = acc[ai][1][m][0], b1 = acc[ai][1][m][1];
                *(f32x4*)((char*)out + off) = a0; *(f32x4*)((char*)out + off + 64) = a1; *(f32x4*)((char*)out + off + 512) = b0; *(f32x4*)((char*)out + off + 576) = b1;
                float s = sq8(a0, a1) + sq8(b0, b1); s += __shfl_xor(s, 16); s += __shfl_xor(s, 32); if (fq == 0) atomicAdd(ssq + row, s);
                off += 16u * DMODEL * 4u; row += 16; OPAQUE(off); OPAQUE(row); MEMFENCE();
            }
            off += 64u * DMODEL * 4u; row += 64;
        }
    }
};

struct AUnit {
    const bf16_t* q; const bf16_t* k; const bf16_t* kr; const bf16_t* v; const bf16_t* gate; bf16_t* y;
    int ldq, ldk, ldg, nkeys, t0, S, head;
};
constexpr int VST = 320;
__device__ __forceinline__ int t5_bucket(int rel) {
    const int n = rel < 0 ? -rel : rel; int b = rel > 0 ? 16 : 0;
    if (n < 8) return b + n;
    int large = 8 + (int)(logf((float)n * 0.125f) / 4.852030263919617f * 8.f);
    return b + (large < 15 ? large : 15);
}
__device__ __forceinline__ s16x4 vtr(const LAS unsigned char* p) { return __builtin_bit_cast(s16x4, __builtin_amdgcn_ds_read_tr16_b64_v4i16((LAS s16x4*)p)); }

template <int MODE>
__device__ __forceinline__ void attn_unit(LAS unsigned char* lds, const AUnit& U, const float* __restrict__ rel_bias) {
    constexpr int DQK = (MODE == 0) ? 192 : 128, KST = DQK * 2 + 16, KBUF = 64 * KST, VBUF = 64 * VST, NKS = DQK / 16;
    constexpr int OFF_V = 2 * KBUF, OFF_TAB = 2 * KBUF + 2 * VBUF;
    int tid = threadIdx.x; OPAQUE(tid);
    const int lane = tid & 63, wid = __builtin_amdgcn_readfirstlane(tid >> 6), r32 = lane & 31, hi = lane >> 5;
    const int srow = tid >> 4, sch = tid & 15, rrow = tid >> 3, rch = tid & 7;
    LAS float* tab = (LAS float*)(lds + OFF_TAB);
    int n0, n1 = 0, n2 = 0, lo0 = 0, lo1 = 0, lo2 = 0;
    if (MODE == 2) {
        const int t0 = U.t0, S = U.S;
        lo0 = t0 - 64 > 0 ? t0 - 64 : 0;     { const int h0 = t0 + 320 < S ? t0 + 320 : S;   n0 = (h0 - lo0) >> 6; }
        lo1 = t0 - 256 > 0 ? t0 - 256 : 0;   { const int h1 = t0 + 512 < S ? t0 + 512 : S;   n1 = (h1 - lo1) >> 6; }
        lo2 = t0 - 1024 > 0 ? t0 - 1024 : 0; { const int h2 = t0 + 1280 < S ? t0 + 1280 : S; n2 = (h2 - lo2) >> 6; }
    } else n0 = U.nkeys >> 6;
    const int total = n0 + n1 + n2;
    u32x4 kA, kB, vA, vB, kR;
#define TILE_G(j) (MODE == 2 ? (((j) >= n0) + ((j) >= n0 + n1)) : 0)
#define TILE_KB(j, g) ((g) == 0 ? lo0 + 64 * (j) : ((g) == 1 ? lo1 + 64 * ((j) - n0) : lo2 + 64 * ((j) - n0 - n1)))
#define LOADT(j) do { const int g_ = TILE_G(j); const int kb_ = TILE_KB(j, g_); \
        kA = *(const u32x4*)(U.k + (size_t)(kb_ + srow) * U.ldk + sch * 8); kB = *(const u32x4*)(U.k + (size_t)(kb_ + srow + 32) * U.ldk + sch * 8); \
        vA = *(const u32x4*)(U.v + (size_t)(kb_ + srow) * U.ldk + sch * 8); vB = *(const u32x4*)(U.v + (size_t)(kb_ + srow + 32) * U.ldk + sch * 8); \
        if (MODE == 0) kR = *(const u32x4*)(U.kr + (size_t)(kb_ + rrow) * 64 + rch * 8); } while (0)
#define WRITET(b) do { LAS unsigned char* kp_ = lds + (b) * KBUF; LAS unsigned char* vp_ = lds + OFF_V + (b) * VBUF; \
        *(LAS u32x4*)(kp_ + srow * KST + sch * 16) = kA; *(LAS u32x4*)(kp_ + (srow + 32) * KST + sch * 16) = kB; \
        *(LAS u32x4*)(vp_ + srow * VST + sch * 16) = vA; *(LAS u32x4*)(vp_ + (srow + 32) * VST + sch * 16) = vB; \
        if (MODE == 0) *(LAS u32x4*)(kp_ + rrow * KST + 256 + rch * 16) = kR; } while (0)

    LOADT(0);
    if (MODE == 2) {
        for (int e = tid; e < 3 * 129; e += 512) { const int g = e / 129, jj = e % 129 - 64; const int dil = g == 0 ? 1 : (g == 1 ? 4 : 16);
            tab[g * 132 + jj + 64] = LOG2E * rel_bias[t5_bucket(jj * dil) * 12 + g * 4 + U.head]; }
    }
    WRITET(0);
    __syncthreads();

    float m_run = -1e30f, l_run = 0.f;
    f32x16 o0 = {}, o1 = {}, o2 = {}, o3 = {};
    bf16x8 qf[NKS];
    int gcur = -1;
    if (wid >= 4) __builtin_amdgcn_s_setprio(2);
    const bf16_t* qrow = U.q + (size_t)(wid * 32 + r32) * U.ldq + hi * 8;
    const int tq = U.t0 + wid * 32 + r32, tw = U.t0 + wid * 32;
    const LAS unsigned char* vlane = lds + OFF_V + (4 * hi + ((lane >> 2) & 3)) * VST + (16 * ((lane >> 4) & 1) + 4 * (lane & 3)) * 2;
    const LAS unsigned char* klane = lds + r32 * KST + hi * 16;

    for (int j = 0; j < total; ++j) {
        const int buf = j & 1;
        const int g = TILE_G(j); const int kb = TILE_KB(j, g);
        if (j + 1 < total) LOADT(j + 1);
        if (g != gcur) { gcur = g;
#pragma unroll
            for (int s = 0; s < NKS; ++s) { qf[s] = *(const bf16x8*)(qrow + (MODE == 2 ? g * 512 : 0) + 16 * s); asm volatile("" : "+v"(qf[s])); } }
        bool active = true;
        int sh = 0;
        if (MODE == 2) { sh = g * 2; const int reach = 64 << sh; active = (kb + 63 >= tw - reach) && (kb <= tw + 31 + reach); }
        if (active) {
            f32x16 s0 = {}, s1 = {};
            const LAS unsigned char* kp = klane + buf * KBUF;
#pragma unroll
            for (int s = 0; s < NKS; ++s) {
                const bf16x8 k0 = *(const LAS bf16x8*)(kp + s * 32), k1 = *(const LAS bf16x8*)(kp + 32 * KST + s * 32);
                s0 = __builtin_amdgcn_mfma_f32_32x32x16_bf16(k0, qf[s], s0, 0, 0, 0);
                s1 = __builtin_amdgcn_mfma_f32_32x32x16_bf16(k1, qf[s], s1, 0, 0, 0);
            }
            if (MODE == 2) {
                const int dmask = (1 << sh) - 1, reach = 64 << sh; const LAS float* tg = tab + g * 132 + 64;
                const int dbase = kb - tq + 4 * hi;
#pragma unroll
                for (int i = 0; i < 16; ++i) {
                    const int d0 = dbase + (i & 3) + 8 * (i >> 2), d1 = d0 + 32;
                    const bool v0 = (d0 >= -reach) && (d0 <= reach) && ((d0 & dmask) == 0);
                    const bool v1 = (d1 >= -reach) && (d1 <= reach) && ((d1 & dmask) == 0);
                    const float b0 = tg[v0 ? (d0 >> sh) : 0], b1 = tg[v1 ? (d1 >> sh) : 0];
                    s0[i] = v0 ? s0[i] + b0 : -1e30f; s1[i] = v1 ? s1[i] + b1 : -1e30f;
                }
            }
            float mx = fmaxf(s0[0], s1[0]);
#pragma unroll
            for (int i = 1; i < 16; ++i) mx = fmaxf(mx, fmaxf(s0[i], s1[i]));
            mx = fmaxf(mx, __shfl_xor(mx, 32));
            if (__any(mx > m_run + 8.f)) {
                const float mnew = fmaxf(m_run, mx); const float alpha = __builtin_amdgcn_exp2f(m_run - mnew); m_run = mnew; l_run *= alpha;
#pragma unroll
                for (int i = 0; i < 16; ++i) { o0[i] *= alpha; o1[i] *= alpha; o2[i] *= alpha; o3[i] *= alpha; }
            }
            float ps = 0.f;
#pragma unroll
            for (int i = 0; i < 16; ++i) { s0[i] = __builtin_amdgcn_exp2f(s0[i] - m_run); s1[i] = __builtin_amdgcn_exp2f(s1[i] - m_run); ps += s0[i] + s1[i]; }
            l_run += ps;
            bf16x8 pf[4];
#pragma unroll
            for (int ks = 0; ks < 2; ++ks) {
                u32x4 w0, w1;
                w0.x = cvt_pk_bf16(s0[8 * ks + 0], s0[8 * ks + 1]); w0.y = cvt_pk_bf16(s0[8 * ks + 2], s0[8 * ks + 3]);
                w0.z = cvt_pk_bf16(s0[8 * ks + 4], s0[8 * ks + 5]); w0.w = cvt_pk_bf16(s0[8 * ks + 6], s0[8 * ks + 7]);
                w1.x = cvt_pk_bf16(s1[8 * ks + 0], s1[8 * ks + 1]); w1.y = cvt_pk_bf16(s1[8 * ks + 2], s1[8 * ks + 3]);
                w1.z = cvt_pk_bf16(s1[8 * ks + 4], s1[8 * ks + 5]); w1.w = cvt_pk_bf16(s1[8 * ks + 6], s1[8 * ks + 7]);
                pf[ks] = __builtin_bit_cast(bf16x8, w0); pf[2 + ks] = __builtin_bit_cast(bf16x8, w1);
            }
            const LAS unsigned char* vp = vlane + buf * VBUF;
#define PV_ONE(OD, DT) do { _Pragma("unroll") for (int ks = 0; ks < 4; ++ks) { \
                const s16x4 lo_ = vtr(vp + (16 * ks) * VST + (DT) * 64), hi_ = vtr(vp + (16 * ks + 8) * VST + (DT) * 64); \
                const bf16x8 vf_ = (bf16x8){lo_[0], lo_[1], lo_[2], lo_[3], hi_[0], hi_[1], hi_[2], hi_[3]}; \
                OD = __builtin_amdgcn_mfma_f32_32x32x16_bf16(vf_, pf[ks], OD, 0, 0, 0); } } while (0)
            PV_ONE(o0, 0); PV_ONE(o1, 1); PV_ONE(o2, 2); PV_ONE(o3, 3);
#undef PV_ONE
        }
        if (j + 1 < total) WRITET(buf ^ 1);
        __syncthreads();
    }
    __builtin_amdgcn_s_setprio(0);
    l_run += __shfl_xor(l_run, 32);
    const float inv = 1.f / l_run;
    const size_t rowoff = (size_t)(wid * 32 + r32);
    const bf16_t* gp = U.gate + rowoff * U.ldg + 4 * hi; bf16_t* yp = U.y + rowoff * DMODEL + 4 * hi;
#define OUT_ONE(OD, DT) do { _Pragma("unroll") for (int q4 = 0; q4 < 4; ++q4) { \
        const u32x2 gw_ = __builtin_nontemporal_load((const u32x2*)(gp + (DT) * 32 + 8 * q4)); \
        const float a0_ = OD[4 * q4 + 0] * inv * silu(bf_lo(gw_.x)), a1_ = OD[4 * q4 + 1] * inv * silu(bf_hi(gw_.x)); \
        const float a2_ = OD[4 * q4 + 2] * inv * silu(bf_lo(gw_.y)), a3_ = OD[4 * q4 + 3] * inv * silu(bf_hi(gw_.y)); \
        u32x2 w_; w_.x = cvt_pk_bf16(a0_, a1_); w_.y = cvt_pk_bf16(a2_, a3_); *(u32x2*)(yp + (DT) * 32 + 8 * q4) = w_; } } while (0)
    OUT_ONE(o0, 0); OUT_ONE(o1, 1); OUT_ONE(o2, 2); OUT_ONE(o3, 3);
#undef OUT_ONE
#undef LOADT
#undef WRITET
#undef TILE_G
#undef TILE_KB
}

__device__ __forceinline__ void attn_mla_unit(LAS unsigned char* lds, const AUnit& U) {
    constexpr int KST = 400, KBUF = 64 * KST, VBUF = 64 * VST, NKS = 12, OFF_V = 2 * KBUF;
    int tid = threadIdx.x; OPAQUE(tid);
    const int lane = tid & 63, wid = __builtin_amdgcn_readfirstlane(tid >> 6), r32 = lane & 31, hi = lane >> 5;
    const int srow = tid >> 4, sch = tid & 15, rrow = tid >> 3, rch = tid & 7;
    const int total = U.nkeys >> 6;
    const bool late = wid >= 4;
    u32x4 kA, kB, vA, vB, kR;
#define LOADT(j) do { const int kb_ = 64 * (j); \
        kA = *(const u32x4*)(U.k + (size_t)(kb_ + srow) * 256 + sch * 8); kB = *(const u32x4*)(U.k + (size_t)(kb_ + srow + 32) * 256 + sch * 8); \
        vA = *(const u32x4*)(U.v + (size_t)(kb_ + srow) * 256 + sch * 8); vB = *(const u32x4*)(U.v + (size_t)(kb_ + srow + 32) * 256 + sch * 8); \
        kR = *(const u32x4*)(U.kr + (size_t)(kb_ + rrow) * 64 + rch * 8); } while (0)
#define WRITEK(b) do { LAS unsigned char* kp_ = lds + (b) * KBUF; \
        *(LAS u32x4*)(kp_ + srow * KST + sch * 16) = kA; *(LAS u32x4*)(kp_ + (srow + 32) * KST + sch * 16) = kB; \
        *(LAS u32x4*)(kp_ + rrow * KST + 256 + rch * 16) = kR; } while (0)
#define WRITEV(b) do { LAS unsigned char* vp_ = lds + OFF_V + (b) * VBUF; \
        *(LAS u32x4*)(vp_ + srow * VST + sch * 16) = vA; *(LAS u32x4*)(vp_ + (srow + 32) * VST + sch * 16) = vB; } while (0)
#define VFRAG(DT, KS) ({ const s16x4 lo_ = vtr(vp_ + (16 * (KS)) * VST + (DT) * 64), hi_ = vtr(vp_ + (16 * (KS) + 8) * VST + (DT) * 64); \
        (bf16x8){lo_[0], lo_[1], lo_[2], lo_[3], hi_[0], hi_[1], hi_[2], hi_[3]}; })
#define PV_STEP(OD, DT, KS, NDT, NKS_) do { bf16x8 nv_ = vcur_; if ((KS) * 4 + (DT) < 15) nv_ = VFRAG(NDT, NKS_); \
        __builtin_amdgcn_sched_barrier(0); OD = __builtin_amdgcn_mfma_f32_32x32x16_bf16(vcur_, pf[KS], OD, 0, 0, 0); __builtin_amdgcn_sched_barrier(0); vcur_ = nv_; } while (0)
#define PV_ALL(vslot) do { const LAS unsigned char* vp_ = vlane + (vslot) * VBUF; bf16x8 vcur_ = VFRAG(0, 0); \
        PV_STEP(o0, 0, 0, 1, 0); PV_STEP(o1, 1, 0, 2, 0); PV_STEP(o2, 2, 0, 3, 0); PV_STEP(o3, 3, 0, 0, 1); \
        PV_STEP(o0, 0, 1, 1, 1); PV_STEP(o1, 1, 1, 2, 1); PV_STEP(o2, 2, 1, 3, 1); PV_STEP(o3, 3, 1, 0, 2); \
        PV_STEP(o0, 0, 2, 1, 2); PV_STEP(o1, 1, 2, 2, 2); PV_STEP(o2, 2, 2, 3, 2); PV_STEP(o3, 3, 2, 0, 3); \
        PV_STEP(o0, 0, 3, 1, 3); PV_STEP(o1, 1, 3, 2, 3); PV_STEP(o2, 2, 3, 3, 3); PV_STEP(o3, 3, 3, 0, 0); } while (0)

    LOADT(0);

    float m_run = -1e30f, l_run = 0.f;
    f32x16 o0 = {}, o1 = {}, o2 = {}, o3 = {};
    bf16x8 qf[NKS], pf[4];
    const bf16_t* qrow = U.q + (size_t)(wid * 32 + r32) * 1536 + hi * 8;
#pragma unroll
    for (int s = 0; s < NKS; ++s) qf[s] = *(const bf16x8*)(qrow + 16 * s);
    WRITEK(0); WRITEV(0);
#pragma unroll
    for (int s = 0; s < NKS; ++s) asm volatile("" : "+v"(qf[s]));
    __syncthreads();
#pragma unroll
    for (int ks = 0; ks < 4; ++ks) pf[ks] = (bf16x8){0, 0, 0, 0, 0, 0, 0, 0};
    const LAS unsigned char* vlane = lds + OFF_V + (4 * hi + ((lane >> 2) & 3)) * VST + (16 * ((lane >> 4) & 1) + 4 * (lane & 3)) * 2;
    const LAS unsigned char* klane = lds + r32 * KST + hi * 16;

    if (wid < 4) __builtin_amdgcn_s_setprio(1);
    int vcur = 0, vprev = 2;
    for (int j = 0; j < total; ++j) {
        const int buf = j & 1;
        const int vnext = vcur == 2 ? 0 : vcur + 1;
        if (j + 1 < total) LOADT(j + 1);
        if (late && j > 0) PV_ALL(vprev);
        f32x16 s0 = {}, s1 = {};
        const LAS unsigned char* kp = klane + buf * KBUF;
        {
            bf16x8 ka = *(const LAS bf16x8*)(kp), kb = *(const LAS bf16x8*)(kp + 32 * KST);
#pragma unroll
            for (int s = 0; s < NKS; ++s) {
                bf16x8 na = ka, nb = kb;
                if (s + 1 < NKS) { na = *(const LAS bf16x8*)(kp + (s + 1) * 32); nb = *(const LAS bf16x8*)(kp + 32 * KST + (s + 1) * 32); }
                __builtin_amdgcn_sched_barrier(0);
                s0 = __builtin_amdgcn_mfma_f32_32x32x16_bf16(ka, qf[s], s0, 0, 0, 0);
                s1 = __builtin_amdgcn_mfma_f32_32x32x16_bf16(kb, qf[s], s1, 0, 0, 0);
                __builtin_amdgcn_sched_barrier(0);
                ka = na; kb = nb;
            }
        }
        if (j == 0) {
            float mx0 = fmaxf(s0[0], s1[0]);
#pragma unroll
            for (int i = 1; i < 16; ++i) mx0 = fmaxf(mx0, fmaxf(s0[i], s1[i]));
            m_run = xhalf_max(mx0);
        }
#pragma unroll
        for (int i = 0; i < 16; ++i) { s0[i] -= m_run; s1[i] -= m_run; }
        float mx = fmaxf(s0[0], s1[0]);
#pragma unroll
        for (int i = 1; i < 16; ++i) mx = fmaxf(mx, fmaxf(s0[i], s1[i]));
        mx = xhalf_max(mx);
        if (__any(mx > 8.f)) {
            const float up = fmaxf(mx, 0.f); const float alpha = __builtin_amdgcn_exp2f(-up); m_run += up; l_run *= alpha;
#pragma unroll
            for (int i = 0; i < 16; ++i) { o0[i] *= alpha; o1[i] *= alpha; o2[i] *= alpha; o3[i] *= alpha; s0[i] -= up; s1[i] -= up; }
        }
        float ps = 0.f;
#pragma unroll
        for (int i = 0; i < 16; ++i) { s0[i] = __builtin_amdgcn_exp2f(s0[i]); s1[i] = __builtin_amdgcn_exp2f(s1[i]); ps += s0[i] + s1[i]; }
        l_run += ps;
#pragma unroll
        for (int ks = 0; ks < 2; ++ks) {
            u32x4 w0, w1;
            w0.x = cvt_pk_bf16(s0[8 * ks + 0], s0[8 * ks + 1]); w0.y = cvt_pk_bf16(s0[8 * ks + 2], s0[8 * ks + 3]);
            w0.z = cvt_pk_bf16(s0[8 * ks + 4], s0[8 * ks + 5]); w0.w = cvt_pk_bf16(s0[8 * ks + 6], s0[8 * ks + 7]);
            w1.x = cvt_pk_bf16(s1[8 * ks + 0], s1[8 * ks + 1]); w1.y = cvt_pk_bf16(s1[8 * ks + 2], s1[8 * ks + 3]);
            w1.z = cvt_pk_bf16(s1[8 * ks + 4], s1[8 * ks + 5]); w1.w = cvt_pk_bf16(s1[8 * ks + 6], s1[8 * ks + 7]);
            pf[ks] = __builtin_bit_cast(bf16x8, w0); pf[2 + ks] = __builtin_bit_cast(bf16x8, w1);
        }
        if (!late) PV_ALL(vcur);
        if (j + 1 < total) { WRITEK(buf ^ 1); WRITEV(vnext); }
        __syncthreads();
        vprev = vcur; vcur = vnext;
    }
    if (late) PV_ALL(vprev);
    __builtin_amdgcn_s_setprio(0);
    __syncthreads();
    l_run = xhalf_sum(l_run);
    const float inv = 1.f / l_run;
    const size_t rowoff = (size_t)(wid * 32 + r32);
    const bf16_t* gp = U.gate + rowoff * NP + 4 * hi; bf16_t* yp = U.y + rowoff * DMODEL + 4 * hi;
#define OUT_ONE(OD, DT) do { _Pragma("unroll") for (int q4 = 0; q4 < 4; ++q4) { \
        const u32x2 gw_ = __builtin_nontemporal_load((const u32x2*)(gp + (DT) * 32 + 8 * q4)); \
        const float a0_ = OD[4 * q4 + 0] * inv * silu(bf_lo(gw_.x)), a1_ = OD[4 * q4 + 1] * inv * silu(bf_hi(gw_.x)); \
        const float a2_ = OD[4 * q4 + 2] * inv * silu(bf_lo(gw_.y)), a3_ = OD[4 * q4 + 3] * inv * silu(bf_hi(gw_.y)); \
        u32x2 w_; w_.x = cvt_pk_bf16(a0_, a1_); w_.y = cvt_pk_bf16(a2_, a3_); *(u32x2*)(yp + (DT) * 32 + 8 * q4) = w_; } } while (0)
    OUT_ONE(o0, 0); OUT_ONE(o1, 1); OUT_ONE(o2, 2); OUT_ONE(o3, 3);
#undef OUT_ONE
#undef PV_ALL
#undef PV_STEP
#undef VFRAG
#undef LOADT
#undef WRITEK
#undef WRITEV
}

__device__ __forceinline__ void attn_dil_unit(LAS unsigned char* lds, const AUnit& U, const float* __restrict__ rel_bias, float* __restrict__ lse_out, int dil, int grp) {
    constexpr int KST = 272, KBUF = 64 * KST, VBUF = 64 * VST, NKS = 8, OFF_V = 2 * KBUF, OFF_TAB = 2 * KBUF + 2 * VBUF;
    int tid = threadIdx.x; OPAQUE(tid);
    const int lane = tid & 63, wid = __builtin_amdgcn_readfirstlane(tid >> 6), r32 = lane & 31, hi = lane >> 5;
    const int srow = tid >> 4, sch = tid & 15;
    LAS float* tab = (LAS float*)(lds + OFF_TAB);
    const int l0 = U.t0, L = U.S;
    const int lo = l0 - 64 > 0 ? l0 - 64 : 0, hiL = l0 + 320 < L ? l0 + 320 : L, total = (hiL - lo) >> 6;
    u32x4 kA, kB, vA, vB;
#define LOADT(j) do { const int kb_ = lo + 64 * (j); \
        kA = *(const u32x4*)(U.k + (size_t)(kb_ + srow) * U.ldk + sch * 8); kB = *(const u32x4*)(U.k + (size_t)(kb_ + srow + 32) * U.ldk + sch * 8); \
        vA = *(const u32x4*)(U.v + (size_t)(kb_ + srow) * U.ldk + sch * 8); vB = *(const u32x4*)(U.v + (size_t)(kb_ + srow + 32) * U.ldk + sch * 8); } while (0)
#define WRITET(b) do { LAS unsigned char* kp_ = lds + (b) * KBUF; LAS unsigned char* vp_ = lds + OFF_V + (b) * VBUF; \
        *(LAS u32x4*)(kp_ + srow * KST + sch * 16) = kA; *(LAS u32x4*)(kp_ + (srow + 32) * KST + sch * 16) = kB; \
        *(LAS u32x4*)(vp_ + srow * VST + sch * 16) = vA; *(LAS u32x4*)(vp_ + (srow + 32) * VST + sch * 16) = vB; } while (0)
    LOADT(0);
    float m_run = -1e30f, l_run = 0.f;
    f32x16 o0 = {}, o1 = {}, o2 = {}, o3 = {};
    bf16x8 qf[NKS];
    bf16_t* qrow = (bf16_t*)U.q + (size_t)(wid * 32 + r32) * U.ldq;
#pragma unroll
    for (int s = 0; s < NKS; ++s) qf[s] = *(const bf16x8*)(qrow + hi * 8 + 16 * s);
    for (int e = tid; e < 129; e += 512) tab[e] = LOG2E * rel_bias[t5_bucket((e - 64) * dil) * 12 + grp * 4 + U.head];
    WRITET(0);
#pragma unroll
    for (int s = 0; s < NKS; ++s) asm volatile("" : "+v"(qf[s]));
    __syncthreads();
    const int lq = l0 + wid * 32 + r32, lw = l0 + wid * 32;
    const LAS unsigned char* vlane = lds + OFF_V + (4 * hi + ((lane >> 2) & 3)) * VST + (16 * ((lane >> 4) & 1) + 4 * (lane & 3)) * 2;
    const LAS unsigned char* klane = lds + r32 * KST + hi * 16;
    const LAS float* tg = tab + 64;
    for (int j = 0; j < total; ++j) {
        const int buf = j & 1; const int kb = lo + 64 * j;
        if (j + 1 < total) LOADT(j + 1);
        if ((kb + 63 >= lw - 64) && (kb <= lw + 95)) {
            f32x16 s0 = {}, s1 = {};
            const LAS unsigned char* kp = klane + buf * KBUF;
            {
                bf16x8 ka = *(const LAS bf16x8*)(kp), kb2 = *(const LAS bf16x8*)(kp + 32 * KST);
#pragma unroll
                for (int s = 0; s < NKS; ++s) {
                    bf16x8 na = ka, nb = kb2;
                    if (s + 1 < NKS) { na = *(const LAS bf16x8*)(kp + (s + 1) * 32); nb = *(const LAS bf16x8*)(kp + 32 * KST + (s + 1) * 32); }
                    __builtin_amdgcn_sched_barrier(0);
                    s0 = __builtin_amdgcn_mfma_f32_32x32x16_bf16(ka, qf[s], s0, 0, 0, 0);
                    s1 = __builtin_amdgcn_mfma_f32_32x32x16_bf16(kb2, qf[s], s1, 0, 0, 0);
                    __builtin_amdgcn_sched_barrier(0);
                    ka = na; kb2 = nb;
                }
            }
            const int dbase = kb - lq + 4 * hi;
#pragma unroll
            for (int i = 0; i < 16; ++i) {
                const int d0 = dbase + (i & 3) + 8 * (i >> 2), d1 = d0 + 32;
                const bool v0 = (d0 >= -64) && (d0 <= 64), v1 = (d1 >= -64) && (d1 <= 64);
                const float b0 = tg[v0 ? d0 : 0], b1 = tg[v1 ? d1 : 0];
                s0[i] = v0 ? s0[i] + b0 : -1e30f; s1[i] = v1 ? s1[i] + b1 : -1e30f;
            }
            float mx = fmaxf(s0[0], s1[0]);
#pragma unroll
            for (int i = 1; i < 16; ++i) mx = fmaxf(mx, fmaxf(s0[i], s1[i]));
            mx = xhalf_max(mx);
            if (__any(mx > m_run + 8.f)) {
                const float mnew = fmaxf(m_run, mx); const float alpha = __builtin_amdgcn_exp2f(m_run - mnew); m_run = mnew; l_run *= alpha;
#pragma unroll
                for (int i = 0; i < 16; ++i) { o0[i] *= alpha; o1[i] *= alpha; o2[i] *= alpha; o3[i] *= alpha; }
            }
            float ps = 0.f;
#pragma unroll
            for (int i = 0; i < 16; ++i) { s0[i] = __builtin_amdgcn_exp2f(s0[i] - m_run); s1[i] = __builtin_amdgcn_exp2f(s1[i] - m_run); ps += s0[i] + s1[i]; }
            l_run += ps;
            bf16x8 pf[4];
#pragma unroll
            for (int ks = 0; ks < 2; ++ks) {
                u32x4 w0, w1;
                w0.x = cvt_pk_bf16(s0[8 * ks + 0], s0[8 * ks + 1]); w0.y = cvt_pk_bf16(s0[8 * ks + 2], s0[8 * ks + 3]);
                w0.z = cvt_pk_bf16(s0[8 * ks + 4], s0[8 * ks + 5]); w0.w = cvt_pk_bf16(s0[8 * ks + 6], s0[8 * ks + 7]);
                w1.x = cvt_pk_bf16(s1[8 * ks + 0], s1[8 * ks + 1]); w1.y = cvt_pk_bf16(s1[8 * ks + 2], s1[8 * ks + 3]);
                w1.z = cvt_pk_bf16(s1[8 * ks + 4], s1[8 * ks + 5]); w1.w = cvt_pk_bf16(s1[8 * ks + 6], s1[8 * ks + 7]);
                pf[ks] = __builtin_bit_cast(bf16x8, w0); pf[2 + ks] = __builtin_bit_cast(bf16x8, w1);
            }
            const LAS unsigned char* vp = vlane + buf * VBUF;
#define PV_ONE(OD, DT) do { _Pragma("unroll") for (int ks = 0; ks < 4; ++ks) { \
                const s16x4 lo_ = vtr(vp + (16 * ks) * VST + (DT) * 64), hi_ = vtr(vp + (16 * ks + 8) * VST + (DT) * 64); \
                const bf16x8 vf_ = (bf16x8){lo_[0], lo_[1], lo_[2], lo_[3], hi_[0], hi_[1], hi_[2], hi_[3]}; \
                OD = __builtin_amdgcn_mfma_f32_32x32x16_bf16(vf_, pf[ks], OD, 0, 0, 0); } } while (0)
            PV_ONE(o0, 0); PV_ONE(o1, 1); PV_ONE(o2, 2); PV_ONE(o3, 3);
#undef PV_ONE
        }
        if (j + 1 < total) WRITET(buf ^ 1);
        __syncthreads();
    }
    l_run = xhalf_sum(l_run);
    const float inv = 1.f / l_run;
    if (hi == 0) lse_out[(size_t)(wid * 32 + r32) * U.ldg] = m_run + log2f(l_run);
    bf16_t* yp = qrow + 4 * hi;
#define OUT_ONE(OD, DT) do { _Pragma("unroll") for (int q4 = 0; q4 < 4; ++q4) { \
        u32x2 w_; w_.x = cvt_pk_bf16(OD[4 * q4 + 0] * inv, OD[4 * q4 + 1] * inv); w_.y = cvt_pk_bf16(OD[4 * q4 + 2] * inv, OD[4 * q4 + 3] * inv); \
        *(u32x2*)(yp + (DT) * 32 + 8 * q4) = w_; } } while (0)
    OUT_ONE(o0, 0); OUT_ONE(o1, 1); OUT_ONE(o2, 2); OUT_ONE(o3, 3);
#undef OUT_ONE
#undef LOADT
#undef WRITET
}

#define XB_TMO      128
#define XB_XCNT(j)  (256  + 64 * (j))
#define XB_XSUB(j)  (1280 + 64 * (j))
#define XB_XGEN(j)  (2304 + 64 * (j))
#define XB_TOP      3328
#define XB_TOPGEN   3392
#define XCD_BAR_WORDS 3456
#define XB_SPIN_CAP (1u << 18)

__device__ __forceinline__ unsigned xb_ld(unsigned* p)              { return __hip_atomic_load(p, __ATOMIC_RELAXED, __HIP_MEMORY_SCOPE_AGENT); }
__device__ __forceinline__ unsigned xb_add(unsigned* p, unsigned v) { return __hip_atomic_fetch_add(p, v, __ATOMIC_RELAXED, __HIP_MEMORY_SCOPE_AGENT); }
__device__ __forceinline__ unsigned xb_xcc_id() { return (unsigned)__builtin_amdgcn_s_getreg((3 << 11) | 20) & 0xFu; }
#define XB_SPIN(cond, bar) do { unsigned _sp = 0; while (cond) { __builtin_amdgcn_s_sleep(1); \
    if ((++_sp & 255u) == 0u) { if (xb_ld(&(bar)[XB_TMO])) break; if (_sp > XB_SPIN_CAP) { atomicAdd(&(bar)[XB_TMO], 1u); break; } } } } while (0)

struct XcdBarrier {
    unsigned* bar; unsigned x;
    volatile LAS unsigned* st;
};

__device__ __forceinline__ XcdBarrier xcd_barrier_post(unsigned* bar, volatile LAS unsigned* st) {
    XcdBarrier b; b.bar = bar; b.x = xb_xcc_id(); b.st = st;
    if (threadIdx.x == 0) (void)xb_add(&bar[XB_XCNT(b.x)], 1u);
    return b;
}
__device__ __forceinline__ void xcd_barrier_complete(unsigned* bar, unsigned x, unsigned& nloc, unsigned& nx) {
    const unsigned G = gridDim.x * gridDim.y * gridDim.z;
    unsigned sum, cnt, mine, sp = 0u;
    for (;;) {
        sum = 0u; cnt = 0u; mine = 0u;
#pragma unroll
        for (unsigned j = 0; j < 16; ++j) { const unsigned c = xb_ld(&bar[XB_XCNT(j)]); sum += c; cnt += (c > 0u) ? 1u : 0u; mine = (j == x) ? c : mine; }
        if (sum == G) break;
        __builtin_amdgcn_s_sleep(1);
        if ((++sp & 255u) == 0u) { if (xb_ld(&bar[XB_TMO])) break; if (sp > XB_SPIN_CAP) { atomicAdd(&bar[XB_TMO], 1u); break; } }
    }
    nloc = mine > 0u ? mine : 1u; nx = cnt > 0u ? cnt : 1u;
}

__device__ __forceinline__ void xcd_barrier(const XcdBarrier& b) {
    asm volatile("s_waitcnt vmcnt(0)" ::: "memory");
    __syncthreads();
    if (threadIdx.x == 0) {
        unsigned* bar = b.bar;
        __builtin_amdgcn_s_waitcnt(0);
        unsigned nloc = b.st[0], nx = b.st[1];
        if (nloc == 0u) { xcd_barrier_complete(bar, b.x, nloc, nx); b.st[0] = nloc; b.st[1] = nx; }
        const unsigned old = xb_add(&bar[XB_XSUB(b.x)], 1u);
        const unsigned gen = old / nloc;
        if (old + 1u == (gen + 1u) * nloc) {
            __builtin_amdgcn_fence(__ATOMIC_RELEASE, "agent");
            asm volatile("s_waitcnt vmcnt(0)" ::: "memory");
            const unsigned og = xb_add(&bar[XB_TOP], 1u);
            const unsigned tg = og / nx;
            if (og + 1u == (tg + 1u) * nx) xb_add(&bar[XB_TOPGEN], 1u);
            else XB_SPIN(xb_ld(&bar[XB_TOPGEN]) == tg, bar);
            __builtin_amdgcn_fence(__ATOMIC_ACQUIRE, "agent");
            xb_add(&bar[XB_XGEN(b.x)], 1u);
            asm volatile("s_waitcnt vmcnt(0)" ::: "memory");
        } else {
            XB_SPIN(xb_ld(&bar[XB_XGEN(b.x)]) == gen, bar);
            __builtin_amdgcn_fence(__ATOMIC_ACQUIRE, "agent");
            asm volatile("s_waitcnt vmcnt(0)" ::: "memory");
        }
    }
    __syncthreads();
}


struct Args { const float* in[15]; float* out; unsigned char* ws; int ph_lo, ph_hi; };

__device__ __forceinline__ void p0_transpose_item(const float* __restrict__ W, int K, int Nsrc, bf16_t* WT, int mode, const float* __restrict__ rowscale,
                                                  LAS float* scr, int item, int nblk, int lane) {
    const int kb = item / nblk, nb = item % nblk, k0 = 64 * kb, n0 = 32 * nb;
    const int n = n0 + (lane & 31);
    int src = n; float cs = 1.f;
    if (mode == 0) {
        if (n < 4096) src = n; else if (n < 6144) src = n + 64; else if (n < 6208) { const int j = n - 6144; src = 4096 + (j >> 1) + 32 * (j & 1); } else src = -1;
        if (n < 1536 || (n >= PC_CQ && n < PC_CG)) cs = QS128;
    } else if (mode == 1) {
        const int hd = n / 192, cm = n % 192;
        if (cm >= 128) { const int j = cm - 128; src = hd * 192 + 128 + (j >> 1) + 32 * (j & 1); }
        cs = QS192;
    }
#pragma unroll 8
    for (int i = 0; i < 32; ++i) { const int kk = 2 * i + (lane >> 5);
        float val = src >= 0 ? __builtin_nontemporal_load(&W[(size_t)(k0 + kk) * Nsrc + src]) : 0.f;
        if (rowscale) val *= rowscale[k0 + kk];
        scr[kk * 33 + (lane & 31)] = val * cs; }
    asm volatile("s_waitcnt lgkmcnt(0)" ::: "memory");
    const int c = lane & 7;
#pragma unroll
    for (int j = 0; j < 4; ++j) { const int nn = (lane >> 3) + 8 * j; const LAS float* s = scr + (8 * c) * 33 + nn;
        u32x4 o; o.x = pk2(s[0 * 33], s[1 * 33]); o.y = pk2(s[2 * 33], s[3 * 33]); o.z = pk2(s[4 * 33], s[5 * 33]); o.w = pk2(s[6 * 33], s[7 * 33]);
        *(u32x4*)(WT + (size_t)(n0 + nn) * K + k0 + 8 * c) = o; }
    asm volatile("s_waitcnt lgkmcnt(0)" ::: "memory");
}
__device__ __forceinline__ void rms_row_to_bf16(const float* __restrict__ xrow, const float* __restrict__ gain, bf16_t* orow, int lane) {
    const f32x4* xr = (const f32x4*)xrow + lane; const f32x4* gr = (const f32x4*)gain + lane;
    f32x4 v[8]; float s = 0.f;
#pragma unroll
    for (int j = 0; j < 8; ++j) { v[j] = __builtin_nontemporal_load(&xr[64 * j]); s += (v[j].x * v[j].x + v[j].y * v[j].y) + (v[j].z * v[j].z + v[j].w * v[j].w); }
    const float rinv = rsqrtf(wave_sum(s) * (1.f / 2048.f) + EPS);
    u32x2* o8 = (u32x2*)orow + lane;
#pragma unroll
    for (int j = 0; j < 8; ++j) { const f32x4 g = gr[64 * j]; u32x2 w; w.x = pk2(v[j].x * rinv * g.x, v[j].y * rinv * g.y); w.y = pk2(v[j].z * rinv * g.z, v[j].w * rinv * g.w); o8[64 * j] = w; }
}

__global__ void __launch_bounds__(512, 2) mega_fwd(Args a) {
    extern __shared__ __attribute__((aligned(16))) unsigned char lds_raw[];
    LAS unsigned char* lds = (LAS unsigned char*)lds_raw;
    const int G = gridDim.x, c = blockIdx.x;
    { volatile LAS unsigned* bar_st0 = (volatile LAS unsigned*)(lds + (LDS_BYTES - 64)); if (threadIdx.x < 2) bar_st0[threadIdx.x] = 0u; }
    __syncthreads();
    if (a.ph_hi - a.ph_lo > 1) (void)xcd_barrier_post((unsigned*)(a.ws + WS_BAR), (volatile LAS unsigned*)(lds + (LDS_BYTES - 64)));
    unsigned char* ws = a.ws;
    float* ssq_q = (float*)(ws + WS_SSQ_Q); float* ssq_kv = (float*)(ws + WS_SSQ_KV); float* ssq_y = (float*)(ws + WS_SSQ_Y);
    float* rope = (float*)(ws + WS_ROPE);
    bf16_t* Wt_in = (bf16_t*)(ws + WS_WIN); bf16_t* Wt_uq = (bf16_t*)(ws + WS_WUQ); bf16_t* Wt_ukv = (bf16_t*)(ws + WS_WUKV);
    bf16_t* Wt_out = (bf16_t*)(ws + WS_WOUT); bf16_t* Wt_mem = (bf16_t*)(ws + WS_WMEM);
    bf16_t* MEMN = (bf16_t*)(ws + WS_MEMN); bf16_t* MKV = (bf16_t*)(ws + WS_MKV); bf16_t* KR = (bf16_t*)(ws + WS_KR);
    bf16_t* H = (bf16_t*)(ws + WS_H); bf16_t* P = (bf16_t*)(ws + WS_P); bf16_t* QB = (bf16_t*)(ws + WS_QB); bf16_t* KVB = (bf16_t*)(ws + WS_KVB);
    bf16_t* Y = H; float* LSE = (float*)(ws + WS_LSE);

    for (int ph = a.ph_lo; ph < a.ph_hi; ++ph) {
        int tid = threadIdx.x; OPAQUE(tid);
        const int lane = tid & 63, wave = __builtin_amdgcn_readfirstlane(tid >> 6);
        if (ph == 0 && (PHM & 1)) {
            LAS float* scr = (LAS float*)(lds + wave * 16384);
            const int gw = c * 8 + wave, NGW = G * 8;
            constexpr int I_IN = 32 * 200, I_UQ = 8 * 48, I_UKV = 8 * 64, I_OUT = 32 * 64, I_MEM = 32 * 32;
            for (int it = gw; it < I_IN + I_UQ + I_UKV + I_OUT + I_MEM; it += NGW) {
                int r = it;
                if (r < I_IN) { p0_transpose_item(a.in[5], 2048, 6208, Wt_in, 0, nullptr, scr, r, 200, lane); continue; } r -= I_IN;
                if (r < I_UQ) { p0_transpose_item(a.in[7], 512, 1536, Wt_uq, 1, a.in[6], scr, r, 48, lane); continue; } r -= I_UQ;
                if (r < I_UKV) { p0_transpose_item(a.in[9], 512, 2048, Wt_ukv, 2, a.in[8], scr, r, 64, lane); continue; } r -= I_UKV;
                if (r < I_OUT) { p0_transpose_item(a.in[12], 2048, 2048, Wt_out, 2, nullptr, scr, r, 64, lane); continue; } r -= I_OUT;
                p0_transpose_item(a.in[11], 2048, 1024, Wt_mem, 2, nullptr, scr, r, 32, lane);
            }
            for (int m = gw; m < NTOK + 1536; m += NGW) {
                if (m < NPROMPT) rms_row_to_bf16(a.in[0] + (size_t)m * 2048, a.in[4], H + (size_t)m * 2048, lane);
                else if (m < NTOK) rms_row_to_bf16(a.in[1] + (size_t)(m - NPROMPT) * 2048, a.in[4], H + (size_t)m * 2048, lane);
                else if (m < NTOK + 1024) rms_row_to_bf16(a.in[2] + (size_t)(m - NTOK) * 2048, a.in[10], MEMN + (size_t)(m - NTOK) * 2048, lane);
                else rms_row_to_bf16(a.in[3] + (size_t)(m - NTOK - 1024) * 2048, a.in[10], MEMN + (size_t)(m - NTOK) * 2048, lane);
            }
            const int gt = c * 512 + tid, NGT = G * 512;
            for (int e = gt; e < 8192 * 32; e += NGT) { const int pos = e >> 5, i = e & 31;
                const float inv = exp2f(-(float)i * (13.287712379549449f / 32.f)); const float ang = (float)pos * inv;
                rope[2 * e] = cosf(ang); rope[2 * e + 1] = sinf(ang); }
            for (int e = gt; e < 3 * NTOK; e += NGT) ((float*)(ws + WS_SSQ_Q))[e] = 0.f;
            __syncthreads();
        } else if (ph == 1 && (PHM & 2)) {
            { pg8::Gemm g{H, Wt_in, 2048, NTOK, N1, 2048}; pg8::StaticOrder S; S.init(NTOK, N1, G, c);
              EpiP1 E{P, KR, ssq_q, ssq_kv, rope};
              pg8::gemm_phase<EpiP1, pg8::StaticOrder>(lds, g, S, E); }
#ifndef NO_G2
            { pg8::Gemm g{MEMN, Wt_mem, 2048, 1536, 1024, 2048}; pg8::StaticOrder S; S.init(1536, 1024, G, G - 1 - c);
              EpiScale E{MKV, 1024, nullptr, 0};
              pg8::gemm_phase<EpiScale, pg8::StaticOrder>(lds, g, S, E); }
#endif
        } else if (ph == 2 && (PHM & 4)) {
#ifndef NO_G1
            { pg8::Gemm g{P + PC_BCQ, Wt_uq, NP, NTOK, 1536, 512}; pg8::StaticOrder S; S.init(NTOK, 1536, G, c);
              EpiQ E{QB, ssq_q, rope};
              pg8::gemm_phase<EpiQ, pg8::StaticOrder>(lds, g, S, E); }
#endif
#ifndef NO_G2
            { pg8::Gemm g{P + PC_BCKV, Wt_ukv, NP, NTOK, 2048, 512}; pg8::StaticOrder S; S.init(NTOK, 2048, G, G - 1 - c);
              EpiScale E{KVB, 256, ssq_kv, 1};
              pg8::gemm_phase<EpiScale, pg8::StaticOrder>(lds, g, S, E); }
#endif
        } else if (ph == 3 && (PHM & 8)) {
            for (int w = c; w < 3840; w += G) {
                AUnit U;
                if (w < 1280) {
                    int seq0, S, head, qblk;
                    if (w < 1024) { const int i = w >> 8, cc = w & 255; const int pair = i * 8 + (cc & 7); qblk = cc >> 3; head = pair & 7; seq0 = (pair >> 3) * 8192; S = 8192; }
                    else { const int cc = w - 1024; const int pair = (cc & 7) * 2 + (cc >> 7); qblk = (cc >> 3) & 15; head = pair & 7; seq0 = NPROMPT + (pair >> 3) * 4096; S = 4096; }
                    const size_t r0 = (size_t)seq0 + qblk * 256;
                    U.q = QB + r0 * 1536 + head * 192; U.ldq = 1536;
                    U.k = KVB + ((size_t)head * NTOK + seq0) * 256; U.v = U.k + 128; U.ldk = 256;
                    U.kr = KR + (size_t)seq0 * 64;
                    U.gate = P + r0 * NP + PC_BG + head * 128; U.ldg = NP;
                    U.y = Y + r0 * DMODEL + 512 + head * 128;
                    U.nkeys = S; U.t0 = 0; U.S = S; U.head = head;
#ifdef DBG_BKEYS
                    U.nkeys = DBG_BKEYS;
#endif
                    attn_mla_unit(lds, U);
                } else if (w < 3200) {
                    const int aidx = w - 1280, g = aidx / 640, rem = aidx - g * 640, head = rem & 3, qb = rem >> 2;
                    int seq0, S, ci;
                    if (qb < 128) { seq0 = (qb >> 5) * 8192; ci = qb & 31; S = 8192; } else { const int q2 = qb - 128; seq0 = NPROMPT + (q2 >> 4) * 4096; ci = q2 & 15; S = 4096; }
                    const int dil = 1 << (2 * g), L = S >> (2 * g), nlb = L >> 8, r = ci / nlb, l0 = (ci - r * nlb) * 256;
                    const size_t row_first = (size_t)seq0 + r + (size_t)dil * l0;
                    U.q = P + row_first * NP + PC_AQ + g * 512 + head * 128; U.ldq = dil * NP;
                    U.k = P + ((size_t)seq0 + r) * NP + PC_AK + head * 128; U.v = P + ((size_t)seq0 + r) * NP + PC_AV + head * 128; U.ldk = dil * NP; U.kr = nullptr;
                    U.gate = nullptr; U.ldg = dil * 4; U.y = nullptr;
                    U.nkeys = L; U.t0 = l0; U.S = L; U.head = head;
                    attn_dil_unit(lds, U, a.in[14], LSE + ((size_t)g * NTOK + row_first) * 4 + head, dil, g);
                } else {
                    const int cidx = w - 3200, head = cidx & 3, qb = cidx >> 2; const int row0 = qb * 256;
                    const int mb = row0 < NPROMPT ? (row0 >> 13) : 4 + ((row0 - NPROMPT) >> 12);
                    U.q = P + (size_t)row0 * NP + PC_CQ + head * 128; U.ldq = NP;
                    U.k = MKV + (size_t)mb * 256 * 1024 + head * 128; U.v = U.k + 512; U.ldk = 1024; U.kr = nullptr;
                    U.gate = P + (size_t)row0 * NP + PC_CG + head * 128; U.ldg = NP;
                    U.y = Y + (size_t)row0 * DMODEL + 1536 + head * 128;
                    U.nkeys = 256; U.t0 = 0; U.S = 256; U.head = head;
                    attn_unit<1>(lds, U, nullptr);
                }
            }
        } else if (ph == 4) {
            const int gw = c * 8 + wave, NGW = G * 8; const int hd = lane >> 4;
            for (int m = gw; m < NTOK; m += NGW) {
                const float l0v = LSE[((size_t)m) * 4 + hd], l1v = LSE[((size_t)NTOK + m) * 4 + hd], l2v = LSE[((size_t)2 * NTOK + m) * 4 + hd];
                const float mxl = fmaxf(l0v, fmaxf(l1v, l2v));
                float e0 = __builtin_amdgcn_exp2f(l0v - mxl), e1 = __builtin_amdgcn_exp2f(l1v - mxl), e2 = __builtin_amdgcn_exp2f(l2v - mxl);
                const float ri = 1.f / (e0 + e1 + e2); e0 *= ri; e1 *= ri; e2 *= ri;
                const bf16_t* prow = P + (size_t)m * NP + lane * 8;
                const u32x4 a0 = __builtin_nontemporal_load((const u32x4*)(prow)), a1 = __builtin_nontemporal_load((const u32x4*)(prow + 512)), a2 = __builtin_nontemporal_load((const u32x4*)(prow + 1024)), gt = __builtin_nontemporal_load((const u32x4*)(prow + PC_AG));
                u32x4 o;
#define MRG(X) { const float lo_ = (e0 * bf_lo(a0.X) + e1 * bf_lo(a1.X) + e2 * bf_lo(a2.X)) * silu(bf_lo(gt.X)); \
                 const float hi_ = (e0 * bf_hi(a0.X) + e1 * bf_hi(a1.X) + e2 * bf_hi(a2.X)) * silu(bf_hi(gt.X)); o.X = cvt_pk_bf16(lo_, hi_); }
                MRG(x) MRG(y) MRG(z) MRG(w)
#undef MRG
                *(u32x4*)(Y + (size_t)m * DMODEL + lane * 8) = o;
            }
        } else if (ph == 5 && (PHM & 16)) {
            pg8::Gemm g{Y, Wt_out, 2048, NTOK, 2048, 2048}; pg8::StaticOrder S; S.init(NTOK, 2048, G, c);
            EpiY E{a.out, ssq_y};
            pg8::gemm_phase<EpiY, pg8::StaticOrder>(lds, g, S, E);
        } else if (ph == 6 && (PHM & 32)) {
            const int gw = c * 8 + wave, NGW = G * 8;
            const f32x4* gr = (const f32x4*)a.in[13] + lane;
            for (int m = gw; m < NTOK; m += NGW) {
                const float* xrow = m < NPROMPT ? a.in[0] + (size_t)m * 2048 : a.in[1] + (size_t)(m - NPROMPT) * 2048;
                const f32x4* xr = (const f32x4*)xrow + lane; f32x4* orow = (f32x4*)(a.out + (size_t)m * 2048) + lane;
                const float rinv = rsqrtf(ssq_y[m] * (1.f / 2048.f) + EPS);
#pragma unroll
                for (int j = 0; j < 8; ++j) { const f32x4 yv = __builtin_nontemporal_load(&orow[64 * j]), xv = __builtin_nontemporal_load(&xr[64 * j]), gv = gr[64 * j]; __builtin_nontemporal_store(xv + yv * rinv * gv, &orow[64 * j]); }
            }
        }
        if (ph + 1 < a.ph_hi) { if (ph == 0) cg::this_grid().sync(); else { XcdBarrier bar; bar.bar = (unsigned*)(a.ws + WS_BAR); bar.x = xb_xcc_id(); bar.st = (volatile LAS unsigned*)(lds + (LDS_BYTES - 64)); xcd_barrier(bar); } }
    }
}


#ifndef DBG
#define DBG 0
#endif
#if DBG
constexpr size_t WS_CHK = 600000;
struct DArgs { const float* in[15]; float* out; unsigned char* ws; int stage, pad; };
__device__ __forceinline__ float bf2f(bf16_t v) { return __builtin_bit_cast(float, (unsigned)v << 16); }
__device__ __forceinline__ void chk_update(unsigned* slot, float got, float ref) { float* f = (float*)slot; float d = got - ref; if (!(d == d)) d = 1e6f; atomicAdd(f, d * d); atomicAdd(f + 16, ref * ref); }
__device__ __forceinline__ const float* xrow_of(const DArgs& a, int row) { return row < NPROMPT ? a.in[0] + (size_t)row * 2048 : a.in[1] + (size_t)(row - NPROMPT) * 2048; }
__global__ void dbg_check(DArgs a) {
    const int gid = blockIdx.x * blockDim.x + threadIdx.x, NT = gridDim.x * blockDim.x;
    unsigned char* ws = a.ws; unsigned* chk = (unsigned*)(ws + WS_CHK);
    const bf16_t* H = (const bf16_t*)(ws + WS_H); const bf16_t* P = (const bf16_t*)(ws + WS_P); const bf16_t* KR = (const bf16_t*)(ws + WS_KR);
    const bf16_t* MEMN = (const bf16_t*)(ws + WS_MEMN); const bf16_t* MKV = (const bf16_t*)(ws + WS_MKV);
    const bf16_t* QB = (const bf16_t*)(ws + WS_QB); const bf16_t* KVB = (const bf16_t*)(ws + WS_KVB); const bf16_t* Y = H;
    const float* ssq_y = (const float*)(ws + WS_SSQ_Y);
    if (a.stage == 1) {
        for (int s = gid; s < 1024; s += NT) {
            const int row = (int)(((unsigned)s * 7919u + 13u) % NTOK), k = (s * 131 + 7) % 2048; const float* xr = xrow_of(a, row);
            float q = 0.f; for (int i = 0; i < 2048; ++i) q += xr[i] * xr[i];
            chk_update(chk + 0, bf2f(H[(size_t)row * 2048 + k]), xr[k] * rsqrtf(q / 2048.f + EPS) * a.in[4][k]);
        }
        for (int s = gid; s < 2048; s += NT) {
            const int row = (int)(((unsigned)s * 7919u + 101u) % NTOK), n = (int)(((unsigned)s * 40503u + 17u) % 6144);
            const int src = n < 4096 ? n : n + 64; const float cs = (n < 1536 || (n >= PC_CQ && n < PC_CG)) ? QS128 : 1.f;
            float acc = 0.f; for (int k = 0; k < 2048; ++k) acc += bf2f(H[(size_t)row * 2048 + k]) * a.in[5][(size_t)k * 6208 + src];
            chk_update(chk + 0, bf2f(P[(size_t)row * NP + n]), acc * cs);
        }
        for (int s = gid; s < 1024; s += NT) {
            const int row = (int)(((unsigned)s * 7919u + 5u) % NTOK), j = s & 63, i = j >> 1;
            float x1 = 0.f, x2 = 0.f; for (int k = 0; k < 2048; ++k) { const float h = bf2f(H[(size_t)row * 2048 + k]); x1 += h * a.in[5][(size_t)k * 6208 + 4096 + i]; x2 += h * a.in[5][(size_t)k * 6208 + 4096 + i + 32]; }
            const float ang = (float)row_pos(row) * exp2f(-(float)i * (13.287712379549449f / 32.f)); const float c = cosf(ang), sn = sinf(ang);
            chk_update(chk + 1, bf2f(KR[(size_t)row * 64 + j]), (j & 1) ? x1 * sn + x2 * c : x1 * c - x2 * sn);
        }
        for (int s = gid; s < 1024; s += NT) {
            const int row = (s * 37 + 3) % 1536, n = (s * 61 + 11) % 1024;
            float acc = 0.f; for (int k = 0; k < 2048; ++k) acc += bf2f(MEMN[(size_t)row * 2048 + k]) * a.in[11][(size_t)k * 1024 + n];
            chk_update(chk + 4, bf2f(MKV[(size_t)row * 1024 + n]), acc);
        }
    } else if (a.stage == 2) {
        for (int s = gid; s < 2048; s += NT) {
            const int row = (int)(((unsigned)s * 7919u + 29u) % NTOK), n = (int)(((unsigned)s * 40503u + 3u) % 1536); const int hd = n / 192, cm = n % 192;
            float q = 0.f; for (int k = 0; k < 512; ++k) { const float v = bf2f(P[(size_t)row * NP + PC_BCQ + k]); q += v * v; }
            const float rinv = rsqrtf(q / 512.f + EPS);
            float ref;
            if (cm < 128) { float acc = 0.f; for (int k = 0; k < 512; ++k) acc += bf2f(P[(size_t)row * NP + PC_BCQ + k]) * a.in[6][k] * a.in[7][(size_t)k * 1536 + n]; ref = acc * rinv * QS192; }
            else { const int j = cm - 128, i = j >> 1; float x1 = 0.f, x2 = 0.f;
                for (int k = 0; k < 512; ++k) { const float v = bf2f(P[(size_t)row * NP + PC_BCQ + k]) * a.in[6][k]; x1 += v * a.in[7][(size_t)k * 1536 + hd * 192 + 128 + i]; x2 += v * a.in[7][(size_t)k * 1536 + hd * 192 + 128 + i + 32]; }
                x1 *= rinv * QS192; x2 *= rinv * QS192;
                const float ang = (float)row_pos(row) * exp2f(-(float)i * (13.287712379549449f / 32.f)); const float c = cosf(ang), sn = sinf(ang);
                ref = (j & 1) ? x1 * sn + x2 * c : x1 * c - x2 * sn; }
            chk_update(chk + 2, bf2f(QB[(size_t)row * 1536 + n]), ref);
        }
        for (int s = gid; s < 2048; s += NT) {
            const int row = (int)(((unsigned)s * 7919u + 31u) % NTOK), n = (int)(((unsigned)s * 40503u + 9u) % 2048);
            float q = 0.f, acc = 0.f; for (int k = 0; k < 512; ++k) { const float v = bf2f(P[(size_t)row * NP + PC_BCKV + k]); q += v * v; acc += v * a.in[8][k] * a.in[9][(size_t)k * 2048 + n]; }
            chk_update(chk + 3, bf2f(KVB[(size_t)row * 2048 + n]), acc * rsqrtf(q / 512.f + EPS));
        }
    } else if (a.stage == 3) {
        const float LN2 = 0.6931471805599453f;
        for (int s = gid; s < 512; s += NT) {
            const int row = (int)(((unsigned)s * 7919u + 77u) % NTOK), head = s & 3, d = (s * 29 + 5) & 127;
            int seq0, S; if (row < NPROMPT) { S = 8192; seq0 = row & ~8191; } else { S = 4096; seq0 = NPROMPT + ((row - NPROMPT) & ~4095); }
            const int t = row - seq0; float og[3], lse[3];
            for (int g = 0; g < 3; ++g) { const int dil = g == 0 ? 1 : (g == 1 ? 4 : 16); float m = -1e30f, den = 0.f, o = 0.f;
                for (int pass = 0; pass < 2; ++pass) for (int j = -64; j <= 64; ++j) { const int tk = t + j * dil; if (tk < 0 || tk >= S) continue;
                    float dot = 0.f; for (int e = 0; e < 128; ++e) dot += bf2f(P[(size_t)row * NP + PC_AQ + g * 512 + head * 128 + e]) * bf2f(P[(size_t)(seq0 + tk) * NP + PC_AK + head * 128 + e]);
                    const float sc = dot * LN2 + a.in[14][t5_bucket(j * dil) * 12 + g * 4 + head];
                    if (pass == 0) m = fmaxf(m, sc); else { const float p = expf(sc - m); den += p; o += p * bf2f(P[(size_t)(seq0 + tk) * NP + PC_AV + head * 128 + d]); } }
                og[g] = o / den; lse[g] = m + logf(den); }
            const float ml = fmaxf(lse[0], fmaxf(lse[1], lse[2])); const float e0 = expf(lse[0] - ml), e1 = expf(lse[1] - ml), e2 = expf(lse[2] - ml);
            const float oa = (e0 * og[0] + e1 * og[1] + e2 * og[2]) / (e0 + e1 + e2); const float gt = bf2f(P[(size_t)row * NP + PC_AG + head * 128 + d]);
            chk_update(chk + 5, bf2f(Y[(size_t)row * 2048 + head * 128 + d]), oa * gt / (1.f + expf(-gt)));
        }
        for (int s = gid; s < 256; s += NT) {
            const int row = (int)(((unsigned)s * 7919u + 55u) % NTOK), head = s & 7, d = (s * 29 + 5) & 127;
            int seq0, S; if (row < NPROMPT) { S = 8192; seq0 = row & ~8191; } else { S = 4096; seq0 = NPROMPT + ((row - NPROMPT) & ~4095); }
            float m = -1e30f, den = 0.f, o = 0.f;
            for (int tk = 0; tk < S; ++tk) { float dot = 0.f;
                for (int e = 0; e < 128; ++e) dot += bf2f(QB[(size_t)row * 1536 + head * 192 + e]) * bf2f(KVB[(size_t)(seq0 + tk) * 2048 + head * 256 + e]);
                for (int e = 0; e < 64; ++e) dot += bf2f(QB[(size_t)row * 1536 + head * 192 + 128 + e]) * bf2f(KR[(size_t)(seq0 + tk) * 64 + e]);
                const float sc = dot * LN2; const float mn = fmaxf(m, sc); const float al = expf(m - mn), p = expf(sc - mn);
                den = den * al + p; o = o * al + p * bf2f(KVB[(size_t)(seq0 + tk) * 2048 + head * 256 + 128 + d]); m = mn; }
            const float gt = bf2f(P[(size_t)row * NP + PC_BG + head * 128 + d]);
            chk_update(chk + 6, bf2f(Y[(size_t)row * 2048 + 512 + head * 128 + d]), o / den * gt / (1.f + expf(-gt)));
        }
        for (int s = gid; s < 512; s += NT) {
            const int row = (int)(((unsigned)s * 7919u + 91u) % NTOK), head = s & 3, d = (s * 29 + 5) & 127;
            const int mb = row < NPROMPT ? (row >> 13) : 4 + ((row - NPROMPT) >> 12);
            float m = -1e30f, den = 0.f, o = 0.f;
            for (int tk = 0; tk < 256; ++tk) { float dot = 0.f;
                for (int e = 0; e < 128; ++e) dot += bf2f(P[(size_t)row * NP + PC_CQ + head * 128 + e]) * bf2f(MKV[(size_t)(mb * 256 + tk) * 1024 + head * 128 + e]);
                const float sc = dot * LN2; const float mn = fmaxf(m, sc); const float al = expf(m - mn), p = expf(sc - mn);
                den = den * al + p; o = o * al + p * bf2f(MKV[(size_t)(mb * 256 + tk) * 1024 + 512 + head * 128 + d]); m = mn; }
            const float gt = bf2f(P[(size_t)row * NP + PC_CG + head * 128 + d]);
            { const float got_ = bf2f(Y[(size_t)row * 2048 + 1536 + head * 128 + d]), ref_ = o / den * gt / (1.f + expf(-gt));
              chk_update(chk + 7, got_, ref_); chk_update(chk + ((row & 31) < 16 ? 9 : 10), got_, ref_); chk_update(chk + (d < 64 ? 11 : 12), got_, ref_); }
        }
    } else if (a.stage == 4) {
        for (int s = gid; s < 1024; s += NT) {
            const int row = (int)(((unsigned)s * 7919u + 41u) % NTOK), n = (int)(((unsigned)s * 40503u + 1u) % 2048);
            float acc = 0.f; for (int k = 0; k < 2048; ++k) acc += bf2f(Y[(size_t)row * 2048 + k]) * a.in[12][(size_t)k * 2048 + n];
            chk_update(chk + 8, a.out[(size_t)row * 2048 + n], acc);
        }
        for (int s = gid; s < 256; s += NT) {
            const int row = (int)(((unsigned)s * 7919u + 43u) % NTOK); float q = 0.f; for (int k = 0; k < 2048; ++k) { const float v = a.out[(size_t)row * 2048 + k]; q += v * v; }
            chk_update(chk + 8, ssq_y[row], q);
        }
    }
}
__global__ void dbg_encode(DArgs a) {
    const float* chf = (const float*)(a.ws + WS_CHK); unsigned chk[9];
    for (int i = 0; i < 9; ++i) chk[i] = (chf[i] > 4e-4f * chf[16 + i] || !(chf[16 + i] > 0.f)) ? 1u : 0u;
    const int code4 = (chk[0] ? 1 : 0) | (chk[1] ? 2 : 0) | (chk[2] ? 4 : 0) | (chk[3] ? 8 : 0);
    const int code5 = (chk[4] ? 1 : 0) | (chk[5] ? 2 : 0) | (chk[6] ? 4 : 0) | (chk[7] ? 8 : 0) | (chk[8] ? 16 : 0);
    const size_t gid = (size_t)blockIdx.x * blockDim.x + threadIdx.x, NT = (size_t)gridDim.x * blockDim.x;
    for (size_t e = gid; e < (size_t)NTOK * 2048; e += NT) { const int row = (int)(e >> 11); const float xv = xrow_of(a, row)[e & 2047];
        float v = ((row & 15) < code4) ? 0.f : xv; if (e == 0 && code5) v = 100.f + 20.f * code5; a.out[e] = v; }
}
#endif

extern "C" void kernel_launch(void* const* d_in, const int* in_sizes, int n_in, void* d_out, int out_size, void* d_ws, size_t ws_size, hipStream_t stream) {
    static int grid = 0;
    if (grid == 0) {
        if (n_in != 15 || out_size != NTOK * DMODEL || ws_size < WS_END) { fprintf(stderr, "kernel_launch: unexpected shapes n_in %d out %d ws %zu\n", n_in, out_size, ws_size); grid = -1; return; }
        int dev = 0, cus = 0, per_cu = 0;
        hipGetDevice(&dev); hipDeviceGetAttribute(&cus, hipDeviceAttributeMultiprocessorCount, dev);
        if (hipFuncSetAttribute((const void*)mega_fwd, hipFuncAttributeMaxDynamicSharedMemorySize, LDS_BYTES) != hipSuccess) { fprintf(stderr, "kernel_launch: hipFuncSetAttribute failed\n"); grid = -1; return; }
        if (hipOccupancyMaxActiveBlocksPerMultiprocessor(&per_cu, (const void*)mega_fwd, 512, LDS_BYTES) != hipSuccess || per_cu < 1) { fprintf(stderr, "kernel_launch: occupancy query gave %d\n", per_cu); per_cu = 1; }
        (void)hipGetLastError();
        grid = cus * per_cu;
    }
    if (grid < 0) return;
    Args a{};
    for (int i = 0; i < 15; ++i) a.in[i] = (const float*)d_in[i];
    a.out = (float*)d_out; a.ws = (unsigned char*)d_ws;
#if MK_SINGLE
    (void)hipMemsetAsync((char*)d_ws + WS_BAR, 0, XCD_BAR_WORDS * 4, stream);
    a.ph_lo = 0; a.ph_hi = 7;
    void* args[] = {&a};
    hipError_t e = hipLaunchCooperativeKernel((const void*)mega_fwd, dim3(grid), dim3(512), args, LDS_BYTES, stream);
    if (e != hipSuccess) fprintf(stderr, "cooperative launch failed: %s (grid %d)\n", hipGetErrorString(e), grid);
#else
#if DBG
    DArgs da{}; for (int i = 0; i < 15; ++i) da.in[i] = (const float*)d_in[i]; da.out = (float*)d_out; da.ws = (unsigned char*)d_ws;
    (void)hipMemsetAsync((char*)d_ws + WS_CHK, 0, 128, stream);
#endif
    for (int ph = 0; ph < 7; ++ph) {
        a.ph_lo = ph; a.ph_hi = ph + 1;
        hipLaunchKernelGGL(mega_fwd, dim3(grid), dim3(512), LDS_BYTES, stream, a);
#if DBG
        if (ph >= 1 && ph <= 4) { da.stage = ph; hipLaunchKernelGGL(dbg_check, dim3(256), dim3(64), 0, stream, da); }
#endif
    }
#if DBG
    hipLaunchKernelGGL(dbg_encode, dim3(2048), dim3(256), 0, stream, da);
#endif
#endif
}
```

```cpp
#include <hip/hip_runtime.h>
#include <hip/hip_cooperative_groups.h>
#include <cstdio>
#include <cstdint>
namespace cg = cooperative_groups;

#ifndef MK_SINGLE
#define MK_SINGLE 1
#endif
#ifndef PHM
#define PHM 63
#endif
#define DBG 0

#define LAS __attribute__((address_space(3)))
#define OPAQUE(x) asm volatile("" : "+v"(x))
#define MEMFENCE() asm volatile("" ::: "memory")
typedef unsigned short bf16_t;
typedef short bf16x8 __attribute__((ext_vector_type(8)));
typedef short s16x4 __attribute__((ext_vector_type(4)));
typedef float f32x4 __attribute__((ext_vector_type(4)));
typedef float f32x16 __attribute__((ext_vector_type(16)));
typedef unsigned u32x4 __attribute__((ext_vector_type(4)));
typedef unsigned u32x2 __attribute__((ext_vector_type(2)));

constexpr int NTOK = 40960, NPROMPT = 32768, DMODEL = 2048;
constexpr int NP = 6144;
constexpr int N1 = 6400;
constexpr int PC_AQ = 0, PC_AK = 1536, PC_AV = 2048, PC_AG = 2560, PC_BCQ = 3072, PC_BCKV = 3584, PC_BG = 4096, PC_CQ = 5120, PC_CG = 5632;
constexpr float LOG2E = 1.4426950408889634f;
constexpr float QS128 = 0.08838834764831845f * LOG2E;
constexpr float QS192 = 0.07216878364870323f * LOG2E;
constexpr float EPS = 1e-6f;

constexpr size_t MiB = 1u << 20;
constexpr size_t WS_SSQ_Q = 0, WS_SSQ_KV = 163840, WS_SSQ_Y = 327680, WS_CTL_BYTES = 491520;
constexpr size_t WS_BAR = 655360;
constexpr size_t WS_ROPE = 1 * MiB;
constexpr size_t WS_WIN = 4 * MiB;
constexpr size_t WS_WUQ = 29 * MiB;
constexpr size_t WS_WUKV = 31 * MiB;
constexpr size_t WS_WOUT = 33 * MiB;
constexpr size_t WS_WMEM = 41 * MiB;
constexpr size_t WS_MEMN = 45 * MiB;
constexpr size_t WS_MKV = 51 * MiB;
constexpr size_t WS_KR = 54 * MiB;
constexpr size_t WS_H = 60 * MiB;
constexpr size_t WS_P = 220 * MiB;
constexpr size_t WS_QB = 700 * MiB;
constexpr size_t WS_KVB = 820 * MiB;
constexpr size_t WS_LSE = 980 * MiB;
constexpr size_t WS_END = 982 * MiB;

constexpr int LDS_BYTES = 147456;

typedef float f32x2_t __attribute__((ext_vector_type(2))); typedef __bf16 bf16x2_t __attribute__((ext_vector_type(2)));
__device__ __forceinline__ unsigned cvt_pk_bf16(float lo, float hi) { f32x2_t v = {lo, hi}; bf16x2_t b = __builtin_convertvector(v, bf16x2_t); return __builtin_bit_cast(unsigned, b); }
__device__ __forceinline__ unsigned f2bf(float f) { unsigned u = __builtin_bit_cast(unsigned, f); return (u + 0x7fffu + ((u >> 16) & 1u)) >> 16; }
__device__ __forceinline__ unsigned pk2(float lo, float hi) { return f2bf(lo) | (f2bf(hi) << 16); }
__device__ __forceinline__ float bf_lo(unsigned w) { return __builtin_bit_cast(float, w << 16); }
__device__ __forceinline__ float bf_hi(unsigned w) { return __builtin_bit_cast(float, w & 0xffff0000u); }
__device__ __forceinline__ float wave_sum(float v) {
#pragma unroll
    for (int o = 1; o < 64; o <<= 1) v += __shfl_xor(v, o);
    return v;
}
__device__ __forceinline__ float xhalf_max(float v) { auto rr = __builtin_amdgcn_permlane32_swap(__float_as_uint(v), __float_as_uint(v), false, false); return fmaxf(__uint_as_float(rr[0]), __uint_as_float(rr[1])); }
__device__ __forceinline__ float xhalf_sum(float v) { auto rr = __builtin_amdgcn_permlane32_swap(__float_as_uint(v), __float_as_uint(v), false, false); return __uint_as_float(rr[0]) + __uint_as_float(rr[1]); }
__device__ __forceinline__ int row_pos(int row) { return row < NPROMPT ? (row & 8191) : (row & 4095); }
__device__ __forceinline__ float silu(float x) { return x / (1.f + __expf(-x)); }

namespace pg8 {
constexpr int BM = 256, BK = 64, HALF = 128, HTB = HALF * BK * 2, STAGE_BYTES = 8 * HTB, NXCD = 8, WGM = 8;
__host__ __device__ __forceinline__ int lds_byte(int r, int c) { const int st = (r >> 4) * 2 + (c >> 5), rr = r & 15, cc = c & 31, ob = rr * 64 + cc * 2; return st * 1024 + (ob ^ (((ob >> 9) & 1) << 5)); }
__host__ __device__ __forceinline__ void stage_rc(int b, int& R, int& C) { const int st = b / 1024, sb = b % 1024, swz = sb ^ (((sb >> 9) & 1) << 5); R = (st >> 1) * 16 + swz / 64; C = (st & 1) * 32 + (swz % 64) / 2; }
__host__ __device__ __forceinline__ int perm32(int rho) { const int n = rho >> 4, i = rho & 15; return 8 * (i >> 2) + 4 * n + (i & 3); }

struct Unit { int pm, pn; };
struct Gemm { const bf16_t* A; const bf16_t* Bt; int lda, M, N, K; };

struct StaticOrder {
    int nM, nN, nwg, G, c;
    __device__ void init(int M, int N, int G_, int c_) { nM = M / BM; nN = N / BM; nwg = nM * nN; G = G_; c = c_; }
    __device__ bool next(int i, Unit& u) const {
        const long L = (long)i * G + c; if (L >= nwg) return false;
        int wgid = (int)L; { const int q = nwg / NXCD, r = nwg % NXCD, xcd = wgid % NXCD, off = wgid / NXCD; wgid = (xcd < r ? xcd * (q + 1) : r * (q + 1) + (xcd - r) * q) + off; }
        const int nig = WGM * nN, gid = wgid / nig, fm = gid * WGM, gsz = (nM - fm) < WGM ? (nM - fm) : WGM;
        u.pm = fm + ((wgid % nig) % gsz); u.pn = (wgid % nig) / gsz; return true;
    }
};

template <class Epi, class Sched>
__device__ __forceinline__ void gemm_phase(LAS unsigned char* lds, const Gemm g, const Sched& S, const Epi& E) {
    int tid = threadIdx.x; OPAQUE(tid);
    const int wid = __builtin_amdgcn_readfirstlane(tid >> 6), lane = tid & 63, wr = wid >> 2, wc = wid & 3, fr = lane & 15, fq = lane >> 4;
    const int K = g.K, nt = K / BK, lda = g.lda;
    unsigned voffA[2], voffB[2];
#pragma unroll
    for (int i = 0; i < 2; ++i) { int R, C; stage_rc(tid * 16 + i * 8192, R, C); const int Rb = Epi::PERM ? (R & ~31) + perm32(R & 31) : R;
        voffA[i] = (unsigned)(R * lda + C) * 2u; voffB[i] = (unsigned)(Rb * K + C) * 2u; }
    const size_t kstep = (size_t)(BK * 2);
    const size_t hstepA = (size_t)HALF * lda * 2, hstepB = (size_t)HALF * K * 2;
    const size_t tstepA = 2 * hstepA, tstepB = 2 * hstepB;
    const unsigned ldsw = (unsigned)wid * 1024u;
    const int aoff = lds_byte(wr * 64 + fr, fq * 8), boff = lds_byte(wc * 32 + fr, fq * 8);
#define PG8_SA(b, h) (((b) * 2 + (h)) * HTB)
#define PG8_SB(b, h) ((4 + (b) * 2 + (h)) * HTB)
#define PG8_STAGE(bufoff, gbase, voff) do { _Pragma("unroll") for (int _i = 0; _i < 2; ++_i) \
        __builtin_amdgcn_global_load_lds((const unsigned*)((const char*)(gbase) + (voff)[_i]), (LAS unsigned*)(lds + (bufoff) + ldsw + _i * 8192), 16, 0, 0); } while (0)
#define PG8_LDA(dst, b, h) do { _Pragma("unroll") for (int m = 0; m < 4; ++m) _Pragma("unroll") for (int k = 0; k < 2; ++k) dst[m][k] = *(const LAS bf16x8*)(lds + PG8_SA(b, h) + aoff + m * 2048 + k * 1024); } while (0)
#define PG8_LDB(dst, b, h) do { _Pragma("unroll") for (int n = 0; n < 2; ++n) _Pragma("unroll") for (int k = 0; k < 2; ++k) dst[n][k] = *(const LAS bf16x8*)(lds + PG8_SB(b, h) + boff + n * 2048 + k * 1024); } while (0)
#define PG8_MMA(ai, bj, At, Bt) do { __builtin_amdgcn_s_setprio(1); _Pragma("unroll") for (int m = 0; m < 4; ++m) _Pragma("unroll") for (int n = 0; n < 2; ++n) _Pragma("unroll") for (int k = 0; k < 2; ++k) \
        acc[ai][bj][m][n] = __builtin_amdgcn_mfma_f32_16x16x32_bf16(Bt[n][k], At[m][k], acc[ai][bj][m][n], 0, 0, 0); __builtin_amdgcn_s_setprio(0); } while (0)
#define PG8_WAIT_V(n) asm volatile("s_waitcnt vmcnt(" #n ")" ::: "memory")
#define PG8_WAIT_L(n) asm volatile("s_waitcnt lgkmcnt(" #n ")" ::: "memory")
#define PG8_BAR __builtin_amdgcn_s_barrier()
#define PG8_SCHED __builtin_amdgcn_sched_barrier(0)
    Unit cur, nxt; int ui = 0;
    if (!S.next(0, cur)) return;
    f32x4 acc[2][2][4][2];
#pragma unroll
    for (int a = 0; a < 2; ++a)
#pragma unroll
        for (int b = 0; b < 2; ++b)
#pragma unroll
            for (int m = 0; m < 4; ++m)
#pragma unroll
                for (int n = 0; n < 2; ++n) acc[a][b][m][n] = (f32x4){0.f, 0.f, 0.f, 0.f};
    bf16x8 At[4][2], B0[2][2], B1[2][2];
    const char* cA = (const char*)g.A + (size_t)cur.pm * tstepA; const char* cB = (const char*)g.Bt + (size_t)cur.pn * tstepB;
    PG8_STAGE(PG8_SB(0, 0), cB, voffB); PG8_STAGE(PG8_SB(0, 1), cB + hstepB, voffB); PG8_STAGE(PG8_SA(0, 0), cA, voffA); PG8_STAGE(PG8_SA(0, 1), cA + hstepA, voffA);
    if (wr == 1) PG8_BAR;
    PG8_WAIT_V(2); PG8_BAR;
    PG8_STAGE(PG8_SB(1, 0), cB + kstep, voffB); PG8_STAGE(PG8_SA(1, 0), cA + kstep, voffA); PG8_STAGE(PG8_SB(1, 1), cB + hstepB + kstep, voffB);
    PG8_WAIT_V(6); PG8_BAR;
    for (;;) {
        const bool has_next = S.next(ui + 1, nxt);
        const char* nA = has_next ? (const char*)g.A + (size_t)nxt.pm * tstepA : cA; const char* nB = has_next ? (const char*)g.Bt + (size_t)nxt.pn * tstepB : cB;
        for (int t = 0; t < nt; t += 2) {
            const bool last = (t == nt - 2);
            const char* a1 = cA + (size_t)(t + 1) * kstep;
            const char* a2 = last ? nA : cA + (size_t)(t + 2) * kstep; const char* b2 = last ? nB : cB + (size_t)(t + 2) * kstep;
            const char* a3 = a2 + kstep; const char* b3 = b2 + kstep;
            PG8_LDB(B0, 0, 0); PG8_LDB(B1, 0, 1); PG8_SCHED; PG8_LDA(At, 0, 0); PG8_STAGE(PG8_SA(1, 1), a1 + hstepA, voffA);
            PG8_WAIT_V(8); PG8_WAIT_L(0); PG8_BAR; PG8_MMA(0, 0, At, B0); PG8_MMA(0, 1, At, B1); PG8_BAR; PG8_SCHED;
            PG8_LDA(At, 0, 1); PG8_STAGE(PG8_SB(0, 0), b2, voffB); PG8_STAGE(PG8_SB(0, 1), b2 + hstepB, voffB); PG8_STAGE(PG8_SA(0, 0), a2, voffA);
            PG8_WAIT_V(8); PG8_WAIT_L(0); PG8_BAR; PG8_MMA(1, 0, At, B0); PG8_MMA(1, 1, At, B1); PG8_BAR; PG8_SCHED;
            PG8_LDB(B0, 1, 0); PG8_LDB(B1, 1, 1); PG8_SCHED; PG8_LDA(At, 1, 0); PG8_STAGE(PG8_SA(0, 1), a2 + hstepA, voffA);
            PG8_WAIT_V(8); PG8_WAIT_L(0); PG8_BAR; PG8_MMA(0, 0, At, B0); PG8_MMA(0, 1, At, B1); PG8_BAR; PG8_SCHED;
            PG8_LDA(At, 1, 1); PG8_STAGE(PG8_SB(1, 0), b3, voffB); PG8_STAGE(PG8_SB(1, 1), b3 + hstepB, voffB); PG8_STAGE(PG8_SA(1, 0), a3, voffA);
            PG8_WAIT_V(8); PG8_WAIT_L(0); PG8_BAR; PG8_MMA(1, 0, At, B0); PG8_MMA(1, 1, At, B1); PG8_BAR; PG8_SCHED;
        }
        if (wr == 0) PG8_BAR;
        E(acc, cur, wr, wc, fr, fq);
        if (!has_next) break;
#pragma unroll
        for (int a = 0; a < 2; ++a)
#pragma unroll
            for (int b = 0; b < 2; ++b)
#pragma unroll
                for (int m = 0; m < 4; ++m)
#pragma unroll
                    for (int n = 0; n < 2; ++n) acc[a][b][m][n] = (f32x4){0.f, 0.f, 0.f, 0.f};
        cur = nxt; cA = nA; cB = nB; ++ui;
        if (wr == 1) PG8_BAR;
    }
    PG8_WAIT_V(0);
    PG8_BAR;
#undef PG8_SA
#undef PG8_SB
#undef PG8_STAGE
#undef PG8_LDA
#undef PG8_LDB
#undef PG8_MMA
#undef PG8_WAIT_V
#undef PG8_WAIT_L
#undef PG8_BAR
#undef PG8_SCHED
}
}

typedef const f32x4 (&AccRef)[2][2][4][2];
__device__ __forceinline__ u32x4 pack8(f32x4 v0, f32x4 v1) { u32x4 w; w.x = cvt_pk_bf16(v0[0], v0[1]); w.y = cvt_pk_bf16(v0[2], v0[3]); w.z = cvt_pk_bf16(v1[0], v1[1]); w.w = cvt_pk_bf16(v1[2], v1[3]); return w; }
__device__ __forceinline__ void rope8(f32x4& v0, f32x4& v1, f32x4 cs0, f32x4 cs1) {
    f32x4 a = v0, b = v1;
    v0[0] = a[0] * cs0[0] - a[1] * cs0[1]; v0[1] = a[0] * cs0[1] + a[1] * cs0[0];
    v0[2] = a[2] * cs0[2] - a[3] * cs0[3]; v0[3] = a[2] * cs0[3] + a[3] * cs0[2];
    v1[0] = b[0] * cs1[0] - b[1] * cs1[1]; v1[1] = b[0] * cs1[1] + b[1] * cs1[0];
    v1[2] = b[2] * cs1[2] - b[3] * cs1[3]; v1[3] = b[2] * cs1[3] + b[3] * cs1[2];
}

__device__ __forceinline__ float sq8(f32x4 v0, f32x4 v1) { return (v0[0] * v0[0] + v0[1] * v0[1]) + (v0[2] * v0[2] + v0[3] * v0[3]) + (v1[0] * v1[0] + v1[1] * v1[1]) + (v1[2] * v1[2] + v1[3] * v1[3]); }
struct EpiP1 {
    static constexpr bool PERM = true;
    bf16_t* P; bf16_t* KR; float* ssq_q; float* ssq_kv; const float* rope;
    __device__ __forceinline__ void operator()(AccRef acc, const pg8::Unit& u, int wr, int wc, int fr, int fq) const {
        int row = u.pm * 256 + wr * 64 + fr;
        if (u.pn < 24) {
            unsigned off = ((unsigned)row * NP + (unsigned)(u.pn * 256 + wc * 32 + 8 * fq)) * 2u;
            float* ssq = (u.pn >= 12 && u.pn < 14) ? ssq_q : ((u.pn >= 14 && u.pn < 16) ? ssq_kv : nullptr);
#pragma unroll
            for (int ai = 0; ai < 2; ++ai) {
#pragma unroll
                for (int m = 0; m < 4; ++m) {
                    const f32x4 a0 = acc[ai][0][m][0], a1 = acc[ai][0][m][1], b0 = acc[ai][1][m][0], b1 = acc[ai][1][m][1];
                    __builtin_nontemporal_store(pack8(a0, a1), (u32x4*)((char*)P + off)); __builtin_nontemporal_store(pack8(b0, b1), (u32x4*)((char*)P + off + 256));
                    if (ssq) { float s = sq8(a0, a1) + sq8(b0, b1); s += __shfl_xor(s, 16); s += __shfl_xor(s, 32); if (fq == 0) atomicAdd(ssq + row, s); }
                    off += 16u * NP * 2u; row += 16; OPAQUE(off); OPAQUE(row); MEMFENCE();
                }
                off += 64u * NP * 2u; row += 64;
            }
        } else if (wc < 2) {
            unsigned off = ((unsigned)row * 64 + (unsigned)(wc * 32 + 8 * fq)) * 2u;
            const unsigned pmask = row < NPROMPT ? 8191u : 4095u;
#pragma unroll
            for (int ai = 0; ai < 2; ++ai) {
#pragma unroll
                for (int m = 0; m < 4; ++m) {
                    const unsigned pos = (unsigned)row & pmask;
                    const float* rp = rope + (pos * 32u + (unsigned)(wc * 16 + 4 * fq)) * 2u;
                    const f32x4 cs0 = *(const f32x4*)rp, cs1 = *(const f32x4*)(rp + 4);
                    f32x4 v0 = acc[ai][0][m][0], v1 = acc[ai][0][m][1];
                    rope8(v0, v1, cs0, cs1);
                    *(u32x4*)((char*)KR + off) = pack8(v0, v1);
                    off += 16u * 64 * 2u; row += 16; OPAQUE(off); OPAQUE(row); MEMFENCE();
                }
                off += 64u * 64 * 2u; row += 64;
            }
        }
    }
};
struct EpiQ {
    static constexpr bool PERM = true;
    bf16_t* QB; const float* ssq; const float* rope;
    __device__ __forceinline__ void operator()(AccRef acc, const pg8::Unit& u, int wr, int wc, int fr, int fq) const {
        int row = u.pm * 256 + wr * 64 + fr; const int colb = u.pn * 256 + wc * 32 + 8 * fq;
        const int cm0 = colb % 192, cm1 = (colb + 128) % 192;
        const unsigned pmask = row < NPROMPT ? 8191u : 4095u;
        unsigned off = ((unsigned)row * 1536 + (unsigned)colb) * 2u;
#pragma unroll
        for (int ai = 0; ai < 2; ++ai) {
#pragma unroll
            for (int m = 0; m < 4; ++m) {
                const unsigned pos = (unsigned)row & pmask;
                const float rinv = rsqrtf(ssq[row] * (1.f / 512.f) + EPS);
                f32x4 a0 = acc[ai][0][m][0] * rinv, a1 = acc[ai][0][m][1] * rinv, b0 = acc[ai][1][m][0] * rinv, b1 = acc[ai][1][m][1] * rinv;
                if (cm0 >= 128) { const float* rp = rope + (pos * 32u + (unsigned)((cm0 - 128) >> 1)) * 2u; rope8(a0, a1, *(const f32x4*)rp, *(const f32x4*)(rp + 4)); }
                if (cm1 >= 128) { const float* rp = rope + (pos * 32u + (unsigned)((cm1 - 128) >> 1)) * 2u; rope8(b0, b1, *(const f32x4*)rp, *(const f32x4*)(rp + 4)); }
                *(u32x4*)((char*)QB + off) = pack8(a0, a1); *(u32x4*)((char*)QB + off + 256) = pack8(b0, b1);
                off += 16u * 1536 * 2u; row += 16; OPAQUE(off); OPAQUE(row); MEMFENCE();
            }
            off += 64u * 1536 * 2u; row += 64;
        }
    }
};
struct EpiScale {
    static constexpr bool PERM = true;
    bf16_t* Ob; int ldc; const float* ssq; int headmajor;
    __device__ __forceinline__ void operator()(AccRef acc, const pg8::Unit& u, int wr, int wc, int fr, int fq) const {
        int row = u.pm * 256 + wr * 64 + fr; const int colb = (headmajor ? 0 : u.pn * 256) + wc * 32 + 8 * fq;
        bf16_t* O = Ob + (headmajor ? (size_t)u.pn * ((size_t)NTOK * 256) : (size_t)0);
        unsigned off = ((unsigned)row * (unsigned)ldc + (unsigned)colb) * 2u; const unsigned rstep = 16u * (unsigned)ldc * 2u;
#pragma unroll
        for (int ai = 0; ai < 2; ++ai) {
#pragma unroll
            for (int m = 0; m < 4; ++m) {
                const float rinv = ssq ? rsqrtf(ssq[row] * (1.f / 512.f) + EPS) : 1.f;
                *(u32x4*)((char*)O + off) = pack8(acc[ai][0][m][0] * rinv, acc[ai][0][m][1] * rinv);
                *(u32x4*)((char*)O + off + 256) = pack8(acc[ai][1][m][0] * rinv, acc[ai][1][m][1] * rinv);
                off += rstep; row += 16; OPAQUE(off); OPAQUE(row); MEMFENCE();
            }
            off += 4u * rstep; row += 64;
        }
    }
};
struct EpiY {
    static constexpr bool PERM = false;
    float* out; float* ssq;
    __device__ __forceinline__ void operator()(AccRef acc, const pg8::Unit& u, int wr, int wc, int fr, int fq) const {
        int row = u.pm * 256 + wr * 64 + fr; const int colb = u.pn * 256 + wc * 32 + 4 * fq;
        unsigned off = ((unsigned)row * DMODEL + (unsigned)colb) * 4u;
#pragma unroll
        for (int ai = 0; ai < 2; ++ai) {
#pragma unroll
            for (int m = 0; m < 4; ++m) {
                const f32x4 a0 = acc[ai][0][m][0], a1 = acc[ai][0][m][1], b0 = acc[ai][1][m][0], b1 = acc[ai][1][m][1];
                __builtin_nontemporal_store(a0, (f32x4*)((char*)out + off)); __builtin_nontemporal_store(a1, (f32x4*)((char*)out + off + 64)); __builtin_nontemporal_store(b0, (f32x4*)((char*)out + off + 512)); __builtin_nontemporal_store(b1, (f32x4*)((char*)out + off + 576));
                float s = sq8(a0, a1) + sq8(b0, b1); s += __shfl_xor(s, 16); s += __shfl_xor(s, 32); if (fq == 0) atomicAdd(ssq + row, s);
                off += 16u * DMODEL * 4u; row += 16; OPAQUE(off); OPAQUE(row); MEMFENCE();
            }
            off += 64u * DMODEL * 4u; row += 64;
        }
    }
};

struct AUnit {
    const bf16_t* q; const bf16_t* k; const bf16_t* kr; const bf16_t* v; const bf16_t* gate; bf16_t* y;
    int ldq, ldk, ldg, nkeys, t0, S, head;
};
constexpr int VST = 320;
__device__ __forceinline__ int t5_bucket(int rel) {
    const int n = rel < 0 ? -rel : rel; int b = rel > 0 ? 16 : 0;
    if (n < 8) return b + n;
    int large = 8 + (int)(logf((float)n * 0.125f) / 4.852030263919617f * 8.f);
    return b + (large < 15 ? large : 15);
}
__device__ __forceinline__ s16x4 vtr(const LAS unsigned char* p) { return __builtin_bit_cast(s16x4, __builtin_amdgcn_ds_read_tr16_b64_v4i16((LAS s16x4*)p)); }

template <int MODE>
__device__ __forceinline__ void attn_unit(LAS unsigned char* lds, const AUnit& U, const float* __restrict__ rel_bias) {
    constexpr int DQK = (MODE == 0) ? 192 : 128, KST = DQK * 2 + 16, KBUF = 64 * KST, VBUF = 64 * VST, NKS = DQK / 16;
    constexpr int OFF_V = 2 * KBUF, OFF_TAB = 2 * KBUF + 2 * VBUF;
    int tid = threadIdx.x; OPAQUE(tid);
    const int lane = tid & 63, wid = __builtin_amdgcn_readfirstlane(tid >> 6), r32 = lane & 31, hi = lane >> 5;
    const int srow = tid >> 4, sch = tid & 15, rrow = tid >> 3, rch = tid & 7;
    LAS float* tab = (LAS float*)(lds + OFF_TAB);
    int n0, n1 = 0, n2 = 0, lo0 = 0, lo1 = 0, lo2 = 0;
    if (MODE == 2) {
        const int t0 = U.t0, S = U.S;
        lo0 = t0 - 64 > 0 ? t0 - 64 : 0;     { const int h0 = t0 + 320 < S ? t0 + 320 : S;   n0 = (h0 - lo0) >> 6; }
        lo1 = t0 - 256 > 0 ? t0 - 256 : 0;   { const int h1 = t0 + 512 < S ? t0 + 512 : S;   n1 = (h1 - lo1) >> 6; }
        lo2 = t0 - 1024 > 0 ? t0 - 1024 : 0; { const int h2 = t0 + 1280 < S ? t0 + 1280 : S; n2 = (h2 - lo2) >> 6; }
    } else n0 = U.nkeys >> 6;
    const int total = n0 + n1 + n2;
    u32x4 kA, kB, vA, vB, kR;
#define TILE_G(j) (MODE == 2 ? (((j) >= n0) + ((j) >= n0 + n1)) : 0)
#define TILE_KB(j, g) ((g) == 0 ? lo0 + 64 * (j) : ((g) == 1 ? lo1 + 64 * ((j) - n0) : lo2 + 64 * ((j) - n0 - n1)))
#define LOADT(j) do { const int g_ = TILE_G(j); const int kb_ = TILE_KB(j, g_); \
        kA = *(const u32x4*)(U.k + (size_t)(kb_ + srow) * U.ldk + sch * 8); kB = *(const u32x4*)(U.k + (size_t)(kb_ + srow + 32) * U.ldk + sch * 8); \
        vA = *(const u32x4*)(U.v + (size_t)(kb_ + srow) * U.ldk + sch * 8); vB = *(const u32x4*)(U.v + (size_t)(kb_ + srow + 32) * U.ldk + sch * 8); \
        if (MODE == 0) kR = *(const u32x4*)(U.kr + (size_t)(kb_ + rrow) * 64 + rch * 8); } while (0)
#define WRITET(b) do { LAS unsigned char* kp_ = lds + (b) * KBUF; LAS unsigned char* vp_ = lds + OFF_V + (b) * VBUF; \
        *(LAS u32x4*)(kp_ + srow * KST + sch * 16) = kA; *(LAS u32x4*)(kp_ + (srow + 32) * KST + sch * 16) = kB; \
        *(LAS u32x4*)(vp_ + srow * VST + sch * 16) = vA; *(LAS u32x4*)(vp_ + (srow + 32) * VST + sch * 16) = vB; \
        if (MODE == 0) *(LAS u32x4*)(kp_ + rrow * KST + 256 + rch * 16) = kR; } while (0)

    LOADT(0);
    if (MODE == 2) {
        for (int e = tid; e < 3 * 129; e += 512) { const int g = e / 129, jj = e % 129 - 64; const int dil = g == 0 ? 1 : (g == 1 ? 4 : 16);
            tab[g * 132 + jj + 64] = LOG2E * rel_bias[t5_bucket(jj * dil) * 12 + g * 4 + U.head]; }
    }
    WRITET(0);
    __syncthreads();

    float m_run = -1e30f, l_run = 0.f;
    f32x16 o0 = {}, o1 = {}, o2 = {}, o3 = {};
    bf16x8 qf[NKS];
    int gcur = -1;
    if (wid >= 4) __builtin_amdgcn_s_setprio(2);
    const bf16_t* qrow = U.q + (size_t)(wid * 32 + r32) * U.ldq + hi * 8;
    const int tq = U.t0 + wid * 32 + r32, tw = U.t0 + wid * 32;
    const LAS unsigned char* vlane = lds + OFF_V + (4 * hi + ((lane >> 2) & 3)) * VST + (16 * ((lane >> 4) & 1) + 4 * (lane & 3)) * 2;
    const LAS unsigned char* klane = lds + r32 * KST + hi * 16;

    for (int j = 0; j < total; ++j) {
        const int buf = j & 1;
        const int g = TILE_G(j); const int kb = TILE_KB(j, g);
        if (j + 1 < total) LOADT(j + 1);
        if (g != gcur) { gcur = g;
#pragma unroll
            for (int s = 0; s < NKS; ++s) { qf[s] = *(const bf16x8*)(qrow + (MODE == 2 ? g * 512 : 0) + 16 * s); asm volatile("" : "+v"(qf[s])); } }
        bool active = true;
        int sh = 0;
        if (MODE == 2) { sh = g * 2; const int reach = 64 << sh; active = (kb + 63 >= tw - reach) && (kb <= tw + 31 + reach); }
        if (active) {
            f32x16 s0 = {}, s1 = {};
            const LAS unsigned char* kp = klane + buf * KBUF;
#pragma unroll
            for (int s = 0; s < NKS; ++s) {
                const bf16x8 k0 = *(const LAS bf16x8*)(kp + s * 32), k1 = *(const LAS bf16x8*)(kp + 32 * KST + s * 32);
                s0 = __builtin_amdgcn_mfma_f32_32x32x16_bf16(k0, qf[s], s0, 0, 0, 0);
                s1 = __builtin_amdgcn_mfma_f32_32x32x16_bf16(k1, qf[s], s1, 0, 0, 0);
            }
            if (MODE == 2) {
                const int dmask = (1 << sh) - 1, reach = 64 << sh; const LAS float* tg = tab + g * 132 + 64;
                const int dbase = kb - tq + 4 * hi;
#pragma unroll
                for (int i = 0; i < 16; ++i) {
                    const int d0 = dbase + (i & 3) + 8 * (i >> 2), d1 = d0 + 32;
                    const bool v0 = (d0 >= -reach) && (d0 <= reach) && ((d0 & dmask) == 0);
                    const bool v1 = (d1 >= -reach) && (d1 <= reach) && ((d1 & dmask) == 0);
                    const float b0 = tg[v0 ? (d0 >> sh) : 0], b1 = tg[v1 ? (d1 >> sh) : 0];
                    s0[i] = v0 ? s0[i] + b0 : -1e30f; s1[i] = v1 ? s1[i] + b1 : -1e30f;
                }
            }
            float mx = fmaxf(s0[0], s1[0]);
#pragma unroll
            for (int i = 1; i < 16; ++i) mx = fmaxf(mx, fmaxf(s0[i], s1[i]));
            mx = fmaxf(mx, __shfl_xor(mx, 32));
            if (__any(mx > m_run + 8.f)) {
                const float mnew = fmaxf(m_run, mx); const float alpha = __builtin_amdgcn_exp2f(m_run - mnew); m_run = mnew; l_run *= alpha;
#pragma unroll
                for (int i = 0; i < 16; ++i) { o0[i] *= alpha; o1[i] *= alpha; o2[i] *= alpha; o3[i] *= alpha; }
            }
            float ps = 0.f;
#pragma unroll
            for (int i = 0; i < 16; ++i) { s0[i] = __builtin_amdgcn_exp2f(s0[i] - m_run); s1[i] = __builtin_amdgcn_exp2f(s1[i] - m_run); ps += s0[i] + s1[i]; }
            l_run += ps;
            bf16x8 pf[4];
#pragma unroll
            for (int ks = 0; ks < 2; ++ks) {
                u32x4 w0, w1;
                w0.x = cvt_pk_bf16(s0[8 * ks + 0], s0[8 * ks + 1]); w0.y = cvt_pk_bf16(s0[8 * ks + 2], s0[8 * ks + 3]);
                w0.z = cvt_pk_bf16(s0[8 * ks + 4], s0[8 * ks + 5]); w0.w = cvt_pk_bf16(s0[8 * ks + 6], s0[8 * ks + 7]);
                w1.x = cvt_pk_bf16(s1[8 * ks + 0], s1[8 * ks + 1]); w1.y = cvt_pk_bf16(s1[8 * ks + 2], s1[8 * ks + 3]);
                w1.z = cvt_pk_bf16(s1[8 * ks + 4], s1[8 * ks + 5]); w1.w = cvt_pk_bf16(s1[8 * ks + 6], s1[8 * ks + 7]);
                pf[ks] = __builtin_bit_cast(bf16x8, w0); pf[2 + ks] = __builtin_bit_cast(bf16x8, w1);
            }
            const LAS unsigned char* vp = vlane + buf * VBUF;
#define PV_ONE(OD, DT) do { _Pragma("unroll") for (int ks = 0; ks < 4; ++ks) { \
                const s16x4 lo_ = vtr(vp + (16 * ks) * VST + (DT) * 64), hi_ = vtr(vp + (16 * ks + 8) * VST + (DT) * 64); \
                const bf16x8 vf_ = (bf16x8){lo_[0], lo_[1], lo_[2], lo_[3], hi_[0], hi_[1], hi_[2], hi_[3]}; \
                OD = __builtin_amdgcn_mfma_f32_32x32x16_bf16(vf_, pf[ks], OD, 0, 0, 0); } } while (0)
            PV_ONE(o0, 0); PV_ONE(o1, 1); PV_ONE(o2, 2); PV_ONE(o3, 3);
#undef PV_ONE
        }
        if (j + 1 < total) WRITET(buf ^ 1);
        __syncthreads();
    }
    __builtin_amdgcn_s_setprio(0);
    l_run += __shfl_xor(l_run, 32);
    const float inv = 1.f / l_run;
    const size_t rowoff = (size_t)(wid * 32 + r32);
    const bf16_t* gp = U.gate + rowoff * U.ldg + 4 * hi; bf16_t* yp = U.y + rowoff * DMODEL + 4 * hi;
#define OUT_ONE(OD, DT) do { _Pragma("unroll") for (int q4 = 0; q4 < 4; ++q4) { \
        const u32x2 gw_ = *(const u32x2*)(gp + (DT) * 32 + 8 * q4); \
        const float a0_ = OD[4 * q4 + 0] * inv * silu(bf_lo(gw_.x)), a1_ = OD[4 * q4 + 1] * inv * silu(bf_hi(gw_.x)); \
        const float a2_ = OD[4 * q4 + 2] * inv * silu(bf_lo(gw_.y)), a3_ = OD[4 * q4 + 3] * inv * silu(bf_hi(gw_.y)); \
        u32x2 w_; w_.x = cvt_pk_bf16(a0_, a1_); w_.y = cvt_pk_bf16(a2_, a3_); *(u32x2*)(yp + (DT) * 32 + 8 * q4) = w_; } } while (0)
    OUT_ONE(o0, 0); OUT_ONE(o1, 1); OUT_ONE(o2, 2); OUT_ONE(o3, 3);
#undef OUT_ONE
#undef LOADT
#undef WRITET
#undef TILE_G
#undef TILE_KB
}

__device__ __forceinline__ void attn_mla_unit(LAS unsigned char* lds, const AUnit& U) {
    constexpr int KST = 400, KBUF = 64 * KST, VBUF = 64 * VST, NKS = 12, OFF_V = 2 * KBUF;
    int tid = threadIdx.x; OPAQUE(tid);
    const int lane = tid & 63, wid = __builtin_amdgcn_readfirstlane(tid >> 6), r32 = lane & 31, hi = lane >> 5;
    const int srow = tid >> 4, sch = tid & 15, rrow = tid >> 3, rch = tid & 7;
    const int total = U.nkeys >> 6;
    const bool late = wid >= 4;
    u32x4 kA, kB, vA, vB, kR;
#define LOADT(j) do { const int kb_ = 64 * (j); \
        kA = *(const u32x4*)(U.k + (size_t)(kb_ + srow) * 256 + sch * 8); kB = *(const u32x4*)(U.k + (size_t)(kb_ + srow + 32) * 256 + sch * 8); \
        vA = *(const u32x4*)(U.v + (size_t)(kb_ + srow) * 256 + sch * 8); vB = *(const u32x4*)(U.v + (size_t)(kb_ + srow + 32) * 256 + sch * 8); \
        kR = *(const u32x4*)(U.kr + (size_t)(kb_ + rrow) * 64 + rch * 8); } while (0)
#define WRITEK(b) do { LAS unsigned char* kp_ = lds + (b) * KBUF; \
        *(LAS u32x4*)(kp_ + srow * KST + sch * 16) = kA; *(LAS u32x4*)(kp_ + (srow + 32) * KST + sch * 16) = kB; \
        *(LAS u32x4*)(kp_ + rrow * KST + 256 + rch * 16) = kR; } while (0)
#define WRITEV(b) do { LAS unsigned char* vp_ = lds + OFF_V + (b) * VBUF; \
        *(LAS u32x4*)(vp_ + srow * VST + sch * 16) = vA; *(LAS u32x4*)(vp_ + (srow + 32) * VST + sch * 16) = vB; } while (0)
#define VFRAG(DT, KS) ({ const s16x4 lo_ = vtr(vp_ + (16 * (KS)) * VST + (DT) * 64), hi_ = vtr(vp_ + (16 * (KS) + 8) * VST + (DT) * 64); \
        (bf16x8){lo_[0], lo_[1], lo_[2], lo_[3], hi_[0], hi_[1], hi_[2], hi_[3]}; })
#define PV_STEP(OD, DT, KS, NDT, NKS_) do { bf16x8 nv_ = vcur_; if ((KS) * 4 + (DT) < 15) nv_ = VFRAG(NDT, NKS_); \
        __builtin_amdgcn_sched_barrier(0); OD = __builtin_amdgcn_mfma_f32_32x32x16_bf16(vcur_, pf[KS], OD, 0, 0, 0); __builtin_amdgcn_sched_barrier(0); vcur_ = nv_; } while (0)
#define PV_ALL(vslot) do { const LAS unsigned char* vp_ = vlane + (vslot) * VBUF; bf16x8 vcur_ = VFRAG(0, 0); \
        PV_STEP(o0, 0, 0, 1, 0); PV_STEP(o1, 1, 0, 2, 0); PV_STEP(o2, 2, 0, 3, 0); PV_STEP(o3, 3, 0, 0, 1); \
        PV_STEP(o0, 0, 1, 1, 1); PV_STEP(o1, 1, 1, 2, 1); PV_STEP(o2, 2, 1, 3, 1); PV_STEP(o3, 3, 1, 0, 2); \
        PV_STEP(o0, 0, 2, 1, 2); PV_STEP(o1, 1, 2, 2, 2); PV_STEP(o2, 2, 2, 3, 2); PV_STEP(o3, 3, 2, 0, 3); \
        PV_STEP(o0, 0, 3, 1, 3); PV_STEP(o1, 1, 3, 2, 3); PV_STEP(o2, 2, 3, 3, 3); PV_STEP(o3, 3, 3, 0, 0); } while (0)

    LOADT(0);

    float m_run = -1e30f, l_run = 0.f;
    f32x16 o0 = {}, o1 = {}, o2 = {}, o3 = {};
    bf16x8 qf[NKS], pf[4];
    const bf16_t* qrow = U.q + (size_t)(wid * 32 + r32) * 1536 + hi * 8;
#pragma unroll
    for (int s = 0; s < NKS; ++s) qf[s] = *(const bf16x8*)(qrow + 16 * s);
    WRITEK(0); WRITEV(0);
#pragma unroll
    for (int s = 0; s < NKS; ++s) asm volatile("" : "+v"(qf[s]));
    __syncthreads();
#pragma unroll
    for (int ks = 0; ks < 4; ++ks) pf[ks] = (bf16x8){0, 0, 0, 0, 0, 0, 0, 0};
    const LAS unsigned char* vlane = lds + OFF_V + (4 * hi + ((lane >> 2) & 3)) * VST + (16 * ((lane >> 4) & 1) + 4 * (lane & 3)) * 2;
    const LAS unsigned char* klane = lds + r32 * KST + hi * 16;

    if (wid < 4) __builtin_amdgcn_s_setprio(1);
    int vcur = 0, vprev = 2;
    for (int j = 0; j < total; ++j) {
        const int buf = j & 1;
        const int vnext = vcur == 2 ? 0 : vcur + 1;
        if (j + 1 < total) LOADT(j + 1);
        if (late && j > 0) PV_ALL(vprev);
        f32x16 s0 = {}, s1 = {};
        const LAS unsigned char* kp = klane + buf * KBUF;
        {
            bf16x8 ka = *(const LAS bf16x8*)(kp), kb = *(const LAS bf16x8*)(kp + 32 * KST);
#pragma unroll
            for (int s = 0; s < NKS; ++s) {
                bf16x8 na = ka, nb = kb;
                if (s + 1 < NKS) { na = *(const LAS bf16x8*)(kp + (s + 1) * 32); nb = *(const LAS bf16x8*)(kp + 32 * KST + (s + 1) * 32); }
                __builtin_amdgcn_sched_barrier(0);
                s0 = __builtin_amdgcn_mfma_f32_32x32x16_bf16(ka, qf[s], s0, 0, 0, 0);
                s1 = __builtin_amdgcn_mfma_f32_32x32x16_bf16(kb, qf[s], s1, 0, 0, 0);
                __builtin_amdgcn_sched_barrier(0);
                ka = na; kb = nb;
            }
        }
        if (j == 0) {
            float mx0 = fmaxf(s0[0], s1[0]);
#pragma unroll
            for (int i = 1; i < 16; ++i) mx0 = fmaxf(mx0, fmaxf(s0[i], s1[i]));
            m_run = xhalf_max(mx0);
        }
#pragma unroll
        for (int i = 0; i < 16; ++i) { s0[i] -= m_run; s1[i] -= m_run; }
        float mx = fmaxf(s0[0], s1[0]);
#pragma unroll
        for (int i = 1; i < 16; ++i) mx = fmaxf(mx, fmaxf(s0[i], s1[i]));
        mx = xhalf_max(mx);
        if (__any(mx > 8.f)) {
            const float up = fmaxf(mx, 0.f); const float alpha = __builtin_amdgcn_exp2f(-up); m_run += up; l_run *= alpha;
#pragma unroll
            for (int i = 0; i < 16; ++i) { o0[i] *= alpha; o1[i] *= alpha; o2[i] *= alpha; o3[i] *= alpha; s0[i] -= up; s1[i] -= up; }
        }
        float ps = 0.f;
#pragma unroll
        for (int i = 0; i < 16; ++i) { s0[i] = __builtin_amdgcn_exp2f(s0[i]); s1[i] = __builtin_amdgcn_exp2f(s1[i]); ps += s0[i] + s1[i]; }
        l_run += ps;
#pragma unroll
        for (int ks = 0; ks < 2; ++ks) {
            u32x4 w0, w1;
            w0.x = cvt_pk_bf16(s0[8 * ks + 0], s0[8 * ks + 1]); w0.y = cvt_pk_bf16(s0[8 * ks + 2], s0[8 * ks + 3]);
            w0.z = cvt_pk_bf16(s0[8 * ks + 4], s0[8 * ks + 5]); w0.w = cvt_pk_bf16(s0[8 * ks + 6], s0[8 * ks + 7]);
            w1.x = cvt_pk_bf16(s1[8 * ks + 0], s1[8 * ks + 1]); w1.y = cvt_pk_bf16(s1[8 * ks + 2], s1[8 * ks + 3]);
            w1.z = cvt_pk_bf16(s1[8 * ks + 4], s1[8 * ks + 5]); w1.w = cvt_pk_bf16(s1[8 * ks + 6], s1[8 * ks + 7]);
            pf[ks] = __builtin_bit_cast(bf16x8, w0); pf[2 + ks] = __builtin_bit_cast(bf16x8, w1);
        }
        if (!late) PV_ALL(vcur);
        if (j + 1 < total) { WRITEK(buf ^ 1); WRITEV(vnext); }
        __syncthreads();
        vprev = vcur; vcur = vnext;
    }
    if (late) PV_ALL(vprev);
    __builtin_amdgcn_s_setprio(0);
    __syncthreads();
    l_run = xhalf_sum(l_run);
    const float inv = 1.f / l_run;
    const size_t rowoff = (size_t)(wid * 32 + r32);
    const bf16_t* gp = U.gate + rowoff * NP + 4 * hi; bf16_t* yp = U.y + rowoff * DMODEL + 4 * hi;
#define OUT_ONE(OD, DT) do { _Pragma("unroll") for (int q4 = 0; q4 < 4; ++q4) { \
        const u32x2 gw_ = *(const u32x2*)(gp + (DT) * 32 + 8 * q4); \
        const float a0_ = OD[4 * q4 + 0] * inv * silu(bf_lo(gw_.x)), a1_ = OD[4 * q4 + 1] * inv * silu(bf_hi(gw_.x)); \
        const float a2_ = OD[4 * q4 + 2] * inv * silu(bf_lo(gw_.y)), a3_ = OD[4 * q4 + 3] * inv * silu(bf_hi(gw_.y)); \
        u32x2 w_; w_.x = cvt_pk_bf16(a0_, a1_); w_.y = cvt_pk_bf16(a2_, a3_); *(u32x2*)(yp + (DT) * 32 + 8 * q4) = w_; } } while (0)
    OUT_ONE(o0, 0); OUT_ONE(o1, 1); OUT_ONE(o2, 2); OUT_ONE(o3, 3);
#undef OUT_ONE
#undef PV_ALL
#undef PV_STEP
#undef VFRAG
#undef LOADT
#undef WRITEK
#undef WRITEV
}

__device__ __forceinline__ void attn_dil_unit(LAS unsigned char* lds, const AUnit& U, const float* __restrict__ rel_bias, float* __restrict__ lse_out, int dil, int grp) {
    constexpr int KST = 272, KBUF = 64 * KST, VBUF = 64 * VST, NKS = 8, OFF_V = 2 * KBUF, OFF_TAB = 2 * KBUF + 2 * VBUF;
    int tid = threadIdx.x; OPAQUE(tid);
    const int lane = tid & 63, wid = __builtin_amdgcn_readfirstlane(tid >> 6), r32 = lane & 31, hi = lane >> 5;
    const int srow = tid >> 4, sch = tid & 15;
    LAS float* tab = (LAS float*)(lds + OFF_TAB);
    const int l0 = U.t0, L = U.S;
    const int lo = l0 - 64 > 0 ? l0 - 64 : 0, hiL = l0 + 320 < L ? l0 + 320 : L, total = (hiL - lo) >> 6;
    u32x4 kA, kB, vA, vB;
#define LOADT(j) do { const int kb_ = lo + 64 * (j); \
        kA = *(const u32x4*)(U.k + (size_t)(kb_ + srow) * U.ldk + sch * 8); kB = *(const u32x4*)(U.k + (size_t)(kb_ + srow + 32) * U.ldk + sch * 8); \
        vA = *(const u32x4*)(U.v + (size_t)(kb_ + srow) * U.ldk + sch * 8); vB = *(const u32x4*)(U.v + (size_t)(kb_ + srow + 32) * U.ldk + sch * 8); } while (0)
#define WRITET(b) do { LAS unsigned char* kp_ = lds + (b) * KBUF; LAS unsigned char* vp_ = lds + OFF_V + (b) * VBUF; \
        *(LAS u32x4*)(kp_ + srow * KST + sch * 16) = kA; *(LAS u32x4*)(kp_ + (srow + 32) * KST + sch * 16) = kB; \
        *(LAS u32x4*)(vp_ + srow * VST + sch * 16) = vA; *(LAS u32x4*)(vp_ + (srow + 32) * VST + sch * 16) = vB; } while (0)
    LOADT(0);
    float m_run = -1e30f, l_run = 0.f;
    f32x16 o0 = {}, o1 = {}, o2 = {}, o3 = {};
    bf16x8 qf[NKS];
    bf16_t* qrow = (bf16_t*)U.q + (size_t)(wid * 32 + r32) * U.ldq;
#pragma unroll
    for (int s = 0; s < NKS; ++s) qf[s] = *(const bf16x8*)(qrow + hi * 8 + 16 * s);
    for (int e = tid; e < 129; e += 512) tab[e] = LOG2E * rel_bias[t5_bucket((e - 64) * dil) * 12 + grp * 4 + U.head];
    WRITET(0);
#pragma unroll
    for (int s = 0; s < NKS; ++s) asm volatile("" : "+v"(qf[s]));
    __syncthreads();
    const int lq = l0 + wid * 32 + r32, lw = l0 + wid * 32;
    const LAS unsigned char* vlane = lds + OFF_V + (4 * hi + ((lane >> 2) & 3)) * VST + (16 * ((lane >> 4) & 1) + 4 * (lane & 3)) * 2;
    const LAS unsigned char* klane = lds + r32 * KST + hi * 16;
    const LAS float* tg = tab + 64;
    for (int j = 0; j < total; ++j) {
        const int buf = j & 1; const int kb = lo + 64 * j;
        if (j + 1 < total) LOADT(j + 1);
        if ((kb + 63 >= lw - 64) && (kb <= lw + 95)) {
            f32x16 s0 = {}, s1 = {};
            const LAS unsigned char* kp = klane + buf * KBUF;
            {
                bf16x8 ka = *(const LAS bf16x8*)(kp), kb2 = *(const LAS bf16x8*)(kp + 32 * KST);
#pragma unroll
                for (int s = 0; s < NKS; ++s) {
                    bf16x8 na = ka, nb = kb2;
                    if (s + 1 < NKS) { na = *(const LAS bf16x8*)(kp + (s + 1) * 32); nb = *(const LAS bf16x8*)(kp + 32 * KST + (s + 1) * 32); }
                    __builtin_amdgcn_sched_barrier(0);
                    s0 = __builtin_amdgcn_mfma_f32_32x32x16_bf16(ka, qf[s], s0, 0, 0, 0);
                    s1 = __builtin_amdgcn_mfma_f32_32x32x16_bf16(kb2, qf[s], s1, 0, 0, 0);
                    __builtin_amdgcn_sched_barrier(0);
                    ka = na; kb2 = nb;
                }
            }
            const int dbase = kb - lq + 4 * hi;
#pragma unroll
            for (int i = 0; i < 16; ++i) {
                const int d0 = dbase + (i & 3) + 8 * (i >> 2), d1 = d0 + 32;
                const bool v0 = (d0 >= -64) && (d0 <= 64), v1 = (d1 >= -64) && (d1 <= 64);
                const float b0 = tg[v0 ? d0 : 0], b1 = tg[v1 ? d1 : 0];
                s0[i] = v0 ? s0[i] + b0 : -1e30f; s1[i] = v1 ? s1[i] + b1 : -1e30f;
            }
            float mx = fmaxf(s0[0], s1[0]);
#pragma unroll
            for (int i = 1; i < 16; ++i) mx = fmaxf(mx, fmaxf(s0[i], s1[i]));
            mx = xhalf_max(mx);
            if (__any(mx > m_run + 8.f)) {
                const float mnew = fmaxf(m_run, mx); const float alpha = __builtin_amdgcn_exp2f(m_run - mnew); m_run = mnew; l_run *= alpha;
#pragma unroll
                for (int i = 0; i < 16; ++i) { o0[i] *= alpha; o1[i] *= alpha; o2[i] *= alpha; o3[i] *= alpha; }
            }
            float ps = 0.f;
#pragma unroll
            for (int i = 0; i < 16; ++i) { s0[i] = __builtin_amdgcn_exp2f(s0[i] - m_run); s1[i] = __builtin_amdgcn_exp2f(s1[i] - m_run); ps += s0[i] + s1[i]; }
            l_run += ps;
            bf16x8 pf[4];
#pragma unroll
            for (int ks = 0; ks < 2; ++ks) {
                u32x4 w0, w1;
                w0.x = cvt_pk_bf16(s0[8 * ks + 0], s0[8 * ks + 1]); w0.y = cvt_pk_bf16(s0[8 * ks + 2], s0[8 * ks + 3]);
                w0.z = cvt_pk_bf16(s0[8 * ks + 4], s0[8 * ks + 5]); w0.w = cvt_pk_bf16(s0[8 * ks + 6], s0[8 * ks + 7]);
                w1.x = cvt_pk_bf16(s1[8 * ks + 0], s1[8 * ks + 1]); w1.y = cvt_pk_bf16(s1[8 * ks + 2], s1[8 * ks + 3]);
                w1.z = cvt_pk_bf16(s1[8 * ks + 4], s1[8 * ks + 5]); w1.w = cvt_pk_bf16(s1[8 * ks + 6], s1[8 * ks + 7]);
                pf[ks] = __builtin_bit_cast(bf16x8, w0); pf[2 + ks] = __builtin_bit_cast(bf16x8, w1);
            }
            const LAS unsigned char* vp = vlane + buf * VBUF;
#define PV_ONE(OD, DT) do { _Pragma("unroll") for (int ks = 0; ks < 4; ++ks) { \
                const s16x4 lo_ = vtr(vp + (16 * ks) * VST + (DT) * 64), hi_ = vtr(vp + (16 * ks + 8) * VST + (DT) * 64); \
                const bf16x8 vf_ = (bf16x8){lo_[0], lo_[1], lo_[2], lo_[3], hi_[0], hi_[1], hi_[2], hi_[3]}; \
                OD = __builtin_amdgcn_mfma_f32_32x32x16_bf16(vf_, pf[ks], OD, 0, 0, 0); } } while (0)
            PV_ONE(o0, 0); PV_ONE(o1, 1); PV_ONE(o2, 2); PV_ONE(o3, 3);
#undef PV_ONE
        }
        if (j + 1 < total) WRITET(buf ^ 1);
        __syncthreads();
    }
    l_run = xhalf_sum(l_run);
    const float inv = 1.f / l_run;
    if (hi == 0) lse_out[(size_t)(wid * 32 + r32) * U.ldg] = m_run + log2f(l_run);
    bf16_t* yp = qrow + 4 * hi;
#define OUT_ONE(OD, DT) do { _Pragma("unroll") for (int q4 = 0; q4 < 4; ++q4) { \
        u32x2 w_; w_.x = cvt_pk_bf16(OD[4 * q4 + 0] * inv, OD[4 * q4 + 1] * inv); w_.y = cvt_pk_bf16(OD[4 * q4 + 2] * inv, OD[4 * q4 + 3] * inv); \
        *(u32x2*)(yp + (DT) * 32 + 8 * q4) = w_; } } while (0)
    OUT_ONE(o0, 0); OUT_ONE(o1, 1); OUT_ONE(o2, 2); OUT_ONE(o3, 3);
#undef OUT_ONE
#undef LOADT
#undef WRITET
}

#define XB_TMO      128
#define XB_XCNT(j)  (256  + 64 * (j))
#define XB_XSUB(j)  (1280 + 64 * (j))
#define XB_XGEN(j)  (2304 + 64 * (j))
#define XB_TOP      3328
#define XB_TOPGEN   3392
#define XCD_BAR_WORDS 3456
#define XB_SPIN_CAP (1u << 18)

__device__ __forceinline__ unsigned xb_ld(unsigned* p)              { return __hip_atomic_load(p, __ATOMIC_RELAXED, __HIP_MEMORY_SCOPE_AGENT); }
__device__ __forceinline__ unsigned xb_add(unsigned* p, unsigned v) { return __hip_atomic_fetch_add(p, v, __ATOMIC_RELAXED, __HIP_MEMORY_SCOPE_AGENT); }
__device__ __forceinline__ unsigned xb_xcc_id() { return (unsigned)__builtin_amdgcn_s_getreg((3 << 11) | 20) & 0xFu; }
#define XB_SPIN(cond, bar) do { unsigned _sp = 0; while (cond) { __builtin_amdgcn_s_sleep(1); \
    if ((++_sp & 255u) == 0u) { if (xb_ld(&(bar)[XB_TMO])) break; if (_sp > XB_SPIN_CAP) { atomicAdd(&(bar)[XB_TMO], 1u); break; } } } } while (0)

struct XcdBarrier {
    unsigned* bar; unsigned x;
    volatile LAS unsigned* st;
};

__device__ __forceinline__ XcdBarrier xcd_barrier_post(unsigned* bar, volatile LAS unsigned* st) {
    XcdBarrier b; b.bar = bar; b.x = xb_xcc_id(); b.st = st;
    if (threadIdx.x == 0) (void)xb_add(&bar[XB_XCNT(b.x)], 1u);
    return b;
}
__device__ __forceinline__ void xcd_barrier_complete(unsigned* bar, unsigned x, unsigned& nloc, unsigned& nx) {
    const unsigned G = gridDim.x * gridDim.y * gridDim.z;
    unsigned sum, cnt, mine, sp = 0u;
    for (;;) {
        sum = 0u; cnt = 0u; mine = 0u;
#pragma unroll
        for (unsigned j = 0; j < 16; ++j) { const unsigned c = xb_ld(&bar[XB_XCNT(j)]); sum += c; cnt += (c > 0u) ? 1u : 0u; mine = (j == x) ? c : mine; }
        if (sum == G) break;
        __builtin_amdgcn_s_sleep(1);
        if ((++sp & 255u) == 0u) { if (xb_ld(&bar[XB_TMO])) break; if (sp > XB_SPIN_CAP) { atomicAdd(&bar[XB_TMO], 1u); break; } }
    }
    nloc = mine > 0u ? mine : 1u; nx = cnt > 0u ? cnt : 1u;
}

__device__ __forceinline__ void xcd_barrier(const XcdBarrier& b) {
    asm volatile("s_waitcnt vmcnt(0)" ::: "memory");
    __syncthreads();
    if (threadIdx.x == 0) {
        unsigned* bar = b.bar;
        __builtin_amdgcn_s_waitcnt(0);
        unsigned nloc = b.st[0], nx = b.st[1];
        if (nloc == 0u) { xcd_barrier_complete(bar, b.x, nloc, nx); b.st[0] = nloc; b.st[1] = nx; }
        const unsigned old = xb_add(&bar[XB_XSUB(b.x)], 1u);
        const unsigned gen = old / nloc;
        if (old + 1u == (gen + 1u) * nloc) {
            __builtin_amdgcn_fence(__ATOMIC_RELEASE, "agent");
            asm volatile("s_waitcnt vmcnt(0)" ::: "memory");
            const unsigned og = xb_add(&bar[XB_TOP], 1u);
            const unsigned tg = og / nx;
            if (og + 1u == (tg + 1u) * nx) xb_add(&bar[XB_TOPGEN], 1u);
            else XB_SPIN(xb_ld(&bar[XB_TOPGEN]) == tg, bar);
            __builtin_amdgcn_fence(__ATOMIC_ACQUIRE, "agent");
            xb_add(&bar[XB_XGEN(b.x)], 1u);
            asm volatile("s_waitcnt vmcnt(0)" ::: "memory");
        } else {
            XB_SPIN(xb_ld(&bar[XB_XGEN(b.x)]) == gen, bar);
            __builtin_amdgcn_fence(__ATOMIC_ACQUIRE, "agent");
            asm volatile("s_waitcnt vmcnt(0)" ::: "memory");
        }
    }
    __syncthreads();
}


struct Args { const float* in[15]; float* out; unsigned char* ws; int ph_lo, ph_hi; };

__device__ __forceinline__ void p0_transpose_item(const float* __restrict__ W, int K, int Nsrc, bf16_t* WT, int mode, const float* __restrict__ rowscale,
                                                  LAS float* scr, int item, int nblk, int lane) {
    const int kb = item / nblk, nb = item % nblk, k0 = 64 * kb, n0 = 32 * nb;
    const int n = n0 + (lane & 31);
    int src = n; float cs = 1.f;
    if (mode == 0) {
        if (n < 4096) src = n; else if (n < 6144) src = n + 64; else if (n < 6208) { const int j = n - 6144; src = 4096 + (j >> 1) + 32 * (j & 1); } else src = -1;
        if (n < 1536 || (n >= PC_CQ && n < PC_CG)) cs = QS128;
    } else if (mode == 1) {
        const int hd = n / 192, cm = n % 192;
        if (cm >= 128) { const int j = cm - 128; src = hd * 192 + 128 + (j >> 1) + 32 * (j & 1); }
        cs = QS192;
    }
#pragma unroll 8
    for (int i = 0; i < 32; ++i) { const int kk = 2 * i + (lane >> 5);
        float val = src >= 0 ? __builtin_nontemporal_load(&W[(size_t)(k0 + kk) * Nsrc + src]) : 0.f;
        if (rowscale) val *= rowscale[k0 + kk];
        scr[kk * 33 + (lane & 31)] = val * cs; }
    asm volatile("s_waitcnt lgkmcnt(0)" ::: "memory");
    const int c = lane & 7;
#pragma unroll
    for (int j = 0; j < 4; ++j) { const int nn = (lane >> 3) + 8 * j; const LAS float* s = scr + (8 * c) * 33 + nn;
        u32x4 o; o.x = pk2(s[0 * 33], s[1 * 33]); o.y = pk2(s[2 * 33], s[3 * 33]); o.z = pk2(s[4 * 33], s[5 * 33]); o.w = pk2(s[6 * 33], s[7 * 33]);
        *(u32x4*)(WT + (size_t)(n0 + nn) * K + k0 + 8 * c) = o; }
    asm volatile("s_waitcnt lgkmcnt(0)" ::: "memory");
}
__device__ __forceinline__ void rms_row_to_bf16(const float* __restrict__ xrow, const float* __restrict__ gain, bf16_t* orow, int lane) {
    const f32x4* xr = (const f32x4*)xrow + lane; const f32x4* gr = (const f32x4*)gain + lane;
    f32x4 v[8]; float s = 0.f;
#pragma unroll
    for (int j = 0; j < 8; ++j) { v[j] = __builtin_nontemporal_load(&xr[64 * j]); s += (v[j].x * v[j].x + v[j].y * v[j].y) + (v[j].z * v[j].z + v[j].w * v[j].w); }
    const float rinv = rsqrtf(wave_sum(s) * (1.f / 2048.f) + EPS);
    u32x2* o8 = (u32x2*)orow + lane;
#pragma unroll
    for (int j = 0; j < 8; ++j) { const f32x4 g = gr[64 * j]; u32x2 w; w.x = pk2(v[j].x * rinv * g.x, v[j].y * rinv * g.y); w.y = pk2(v[j].z * rinv * g.z, v[j].w * rinv * g.w); o8[64 * j] = w; }
}

__global__ void __launch_bounds__(512, 2) mega_fwd(Args a) {
    extern __shared__ __attribute__((aligned(16))) unsigned char lds_raw[];
    LAS unsigned char* lds = (LAS unsigned char*)lds_raw;
    const int G = gridDim.x, c = blockIdx.x;
    { volatile LAS unsigned* bar_st0 = (volatile LAS unsigned*)(lds + (LDS_BYTES - 64)); if (threadIdx.x < 2) bar_st0[threadIdx.x] = 0u; }
    __syncthreads();
    if (a.ph_hi - a.ph_lo > 1) (void)xcd_barrier_post((unsigned*)(a.ws + WS_BAR), (volatile LAS unsigned*)(lds + (LDS_BYTES - 64)));
    unsigned char* ws = a.ws;
    float* ssq_q = (float*)(ws + WS_SSQ_Q); float* ssq_kv = (float*)(ws + WS_SSQ_KV); float* ssq_y = (float*)(ws + WS_SSQ_Y);
    float* rope = (float*)(ws + WS_ROPE);
    bf16_t* Wt_in = (bf16_t*)(ws + WS_WIN); bf16_t* Wt_uq = (bf16_t*)(ws + WS_WUQ); bf16_t* Wt_ukv = (bf16_t*)(ws + WS_WUKV);
    bf16_t* Wt_out = (bf16_t*)(ws + WS_WOUT); bf16_t* Wt_mem = (bf16_t*)(ws + WS_WMEM);
    bf16_t* MEMN = (bf16_t*)(ws + WS_MEMN); bf16_t* MKV = (bf16_t*)(ws + WS_MKV); bf16_t* KR = (bf16_t*)(ws + WS_KR);
    bf16_t* H = (bf16_t*)(ws + WS_H); bf16_t* P = (bf16_t*)(ws + WS_P); bf16_t* QB = (bf16_t*)(ws + WS_QB); bf16_t* KVB = (bf16_t*)(ws + WS_KVB);
    bf16_t* Y = H; float* LSE = (float*)(ws + WS_LSE);

    for (int ph = a.ph_lo; ph < a.ph_hi; ++ph) {
        int tid = threadIdx.x; OPAQUE(tid);
        const int lane = tid & 63, wave = __builtin_amdgcn_readfirstlane(tid >> 6);
        if (ph == 0 && (PHM & 1)) {
            LAS float* scr = (LAS float*)(lds + wave * 16384);
            const int gw = c * 8 + wave, NGW = G * 8;
            constexpr int I_IN = 32 * 200, I_UQ = 8 * 48, I_UKV = 8 * 64, I_OUT = 32 * 64, I_MEM = 32 * 32;
            for (int it = gw; it < I_IN + I_UQ + I_UKV + I_OUT + I_MEM; it += NGW) {
                int r = it;
                if (r < I_IN) { p0_transpose_item(a.in[5], 2048, 6208, Wt_in, 0, nullptr, scr, r, 200, lane); continue; } r -= I_IN;
                if (r < I_UQ) { p0_transpose_item(a.in[7], 512, 1536, Wt_uq, 1, a.in[6], scr, r, 48, lane); continue; } r -= I_UQ;
                if (r < I_UKV) { p0_transpose_item(a.in[9], 512, 2048, Wt_ukv, 2, a.in[8], scr, r, 64, lane); continue; } r -= I_UKV;
                if (r < I_OUT) { p0_transpose_item(a.in[12], 2048, 2048, Wt_out, 2, nullptr, scr, r, 64, lane); continue; } r -= I_OUT;
                p0_transpose_item(a.in[11], 2048, 1024, Wt_mem, 2, nullptr, scr, r, 32, lane);
            }
            for (int m = gw; m < NTOK + 1536; m += NGW) {
                if (m < NPROMPT) rms_row_to_bf16(a.in[0] + (size_t)m * 2048, a.in[4], H + (size_t)m * 2048, lane);
                else if (m < NTOK) rms_row_to_bf16(a.in[1] + (size_t)(m - NPROMPT) * 2048, a.in[4], H + (size_t)m * 2048, lane);
                else if (m < NTOK + 1024) rms_row_to_bf16(a.in[2] + (size_t)(m - NTOK) * 2048, a.in[10], MEMN + (size_t)(m - NTOK) * 2048, lane);
                else rms_row_to_bf16(a.in[3] + (size_t)(m - NTOK - 1024) * 2048, a.in[10], MEMN + (size_t)(m - NTOK) * 2048, lane);
            }
            const int gt = c * 512 + tid, NGT = G * 512;
            for (int e = gt; e < 8192 * 32; e += NGT) { const int pos = e >> 5, i = e & 31;
                const float inv = exp2f(-(float)i * (13.287712379549449f / 32.f)); const float ang = (float)pos * inv;
                rope[2 * e] = cosf(ang); rope[2 * e + 1] = sinf(ang); }
            for (int e = gt; e < 3 * NTOK; e += NGT) ((float*)(ws + WS_SSQ_Q))[e] = 0.f;
            __syncthreads();
        } else if (ph == 1 && (PHM & 2)) {
            { pg8::Gemm g{H, Wt_in, 2048, NTOK, N1, 2048}; pg8::StaticOrder S; S.init(NTOK, N1, G, c);
              EpiP1 E{P, KR, ssq_q, ssq_kv, rope};
              pg8::gemm_phase<EpiP1, pg8::StaticOrder>(lds, g, S, E); }
#ifndef NO_G2
            { pg8::Gemm g{MEMN, Wt_mem, 2048, 1536, 1024, 2048}; pg8::StaticOrder S; S.init(1536, 1024, G, G - 1 - c);
              EpiScale E{MKV, 1024, nullptr, 0};
              pg8::gemm_phase<EpiScale, pg8::StaticOrder>(lds, g, S, E); }
#endif
        } else if (ph == 2 && (PHM & 4)) {
#ifndef NO_G1
            { pg8::Gemm g{P + PC_BCQ, Wt_uq, NP, NTOK, 1536, 512}; pg8::StaticOrder S; S.init(NTOK, 1536, G, c);
              EpiQ E{QB, ssq_q, rope};
              pg8::gemm_phase<EpiQ, pg8::StaticOrder>(lds, g, S, E); }
#endif
#ifndef NO_G2
            { pg8::Gemm g{P + PC_BCKV, Wt_ukv, NP, NTOK, 2048, 512}; pg8::StaticOrder S; S.init(NTOK, 2048, G, G - 1 - c);
              EpiScale E{KVB, 256, ssq_kv, 1};
              pg8::gemm_phase<EpiScale, pg8::StaticOrder>(lds, g, S, E); }
#endif
        } else if (ph == 3 && (PHM & 8)) {
            for (int w = c; w < 3840; w += G) {
                AUnit U;
                if (w < 1280) {
                    int seq0, S, head, qblk;
                    if (w < 1024) { const int i = w >> 8, cc = w & 255; const int pair = i * 8 + (cc & 7); qblk = cc >> 3; head = pair & 7; seq0 = (pair >> 3) * 8192; S = 8192; }
                    else { const int cc = w - 1024; const int pair = (cc & 7) * 2 + (cc >> 7); qblk = (cc >> 3) & 15; head = pair & 7; seq0 = NPROMPT + (pair >> 3) * 4096; S = 4096; }
                    const size_t r0 = (size_t)seq0 + qblk * 256;
                    U.q = QB + r0 * 1536 + head * 192; U.ldq = 1536;
                    U.k = KVB + ((size_t)head * NTOK + seq0) * 256; U.v = U.k + 128; U.ldk = 256;
                    U.kr = KR + (size_t)seq0 * 64;
                    U.gate = P + r0 * NP + PC_BG + head * 128; U.ldg = NP;
                    U.y = Y + r0 * DMODEL + 512 + head * 128;
                    U.nkeys = S; U.t0 = 0; U.S = S; U.head = head;
#ifdef DBG_BKEYS
                    U.nkeys = DBG_BKEYS;
#endif
                    attn_mla_unit(lds, U);
                } else if (w < 3200) {
                    const int aidx = w - 1280, g = aidx / 640, rem = aidx - g * 640, head = rem & 3, qb = rem >> 2;
                    int seq0, S, ci;
                    if (qb < 128) { seq0 = (qb >> 5) * 8192; ci = qb & 31; S = 8192; } else { const int q2 = qb - 128; seq0 = NPROMPT + (q2 >> 4) * 4096; ci = q2 & 15; S = 4096; }
                    const int dil = 1 << (2 * g), L = S >> (2 * g), nlb = L >> 8, r = ci / nlb, l0 = (ci - r * nlb) * 256;
                    const size_t row_first = (size_t)seq0 + r + (size_t)dil * l0;
                    U.q = P + row_first * NP + PC_AQ + g * 512 + head * 128; U.ldq = dil * NP;
                    U.k = P + ((size_t)seq0 + r) * NP + PC_AK + head * 128; U.v = P + ((size_t)seq0 + r) * NP + PC_AV + head * 128; U.ldk = dil * NP; U.kr = nullptr;
                    U.gate = nullptr; U.ldg = dil * 4; U.y = nullptr;
                    U.nkeys = L; U.t0 = l0; U.S = L; U.head = head;
                    attn_dil_unit(lds, U, a.in[14], LSE + ((size_t)g * NTOK + row_first) * 4 + head, dil, g);
                } else {
                    const int cidx = w - 3200, head = cidx & 3, qb = cidx >> 2; const int row0 = qb * 256;
                    const int mb = row0 < NPROMPT ? (row0 >> 13) : 4 + ((row0 - NPROMPT) >> 12);
                    U.q = P + (size_t)row0 * NP + PC_CQ + head * 128; U.ldq = NP;
                    U.k = MKV + (size_t)mb * 256 * 1024 + head * 128; U.v = U.k + 512; U.ldk = 1024; U.kr = nullptr;
                    U.gate = P + (size_t)row0 * NP + PC_CG + head * 128; U.ldg = NP;
                    U.y = Y + (size_t)row0 * DMODEL + 1536 + head * 128;
                    U.nkeys = 256; U.t0 = 0; U.S = 256; U.head = head;
                    attn_unit<1>(lds, U, nullptr);
                }
            }
        } else if (ph == 4) {
            const int gw = c * 8 + wave, NGW = G * 8; const int hd = lane >> 4;
            for (int m = gw; m < NTOK; m += NGW) {
                const float l0v = LSE[((size_t)m) * 4 + hd], l1v = LSE[((size_t)NTOK + m) * 4 + hd], l2v = LSE[((size_t)2 * NTOK + m) * 4 + hd];
                const float mxl = fmaxf(l0v, fmaxf(l1v, l2v));
                float e0 = __builtin_amdgcn_exp2f(l0v - mxl), e1 = __builtin_amdgcn_exp2f(l1v - mxl), e2 = __builtin_amdgcn_exp2f(l2v - mxl);
                const float ri = 1.f / (e0 + e1 + e2); e0 *= ri; e1 *= ri; e2 *= ri;
                const bf16_t* prow = P + (size_t)m * NP + lane * 8;
                const u32x4 a0 = *(const u32x4*)(prow), a1 = *(const u32x4*)(prow + 512), a2 = *(const u32x4*)(prow + 1024), gt = *(const u32x4*)(prow + PC_AG);
                u32x4 o;
#define MRG(X) { const float lo_ = (e0 * bf_lo(a0.X) + e1 * bf_lo(a1.X) + e2 * bf_lo(a2.X)) * silu(bf_lo(gt.X)); \
                 const float hi_ = (e0 * bf_hi(a0.X) + e1 * bf_hi(a1.X) + e2 * bf_hi(a2.X)) * silu(bf_hi(gt.X)); o.X = cvt_pk_bf16(lo_, hi_); }
                MRG(x) MRG(y) MRG(z) MRG(w)
#undef MRG
                *(u32x4*)(Y + (size_t)m * DMODEL + lane * 8) = o;
            }
        } else if (ph == 5 && (PHM & 16)) {
            pg8::Gemm g{Y, Wt_out, 2048, NTOK, 2048, 2048}; pg8::StaticOrder S; S.init(NTOK, 2048, G, c);
            EpiY E{a.out, ssq_y};
            pg8::gemm_phase<EpiY, pg8::StaticOrder>(lds, g, S, E);
        } else if (ph == 6 && (PHM & 32)) {
            const int gw = c * 8 + wave, NGW = G * 8;
            const f32x4* gr = (const f32x4*)a.in[13] + lane;
            for (int m = gw; m < NTOK; m += NGW) {
                const float* xrow = m < NPROMPT ? a.in[0] + (size_t)m * 2048 : a.in[1] + (size_t)(m - NPROMPT) * 2048;
                const f32x4* xr = (const f32x4*)xrow + lane; f32x4* orow = (f32x4*)(a.out + (size_t)m * 2048) + lane;
                const float rinv = rsqrtf(ssq_y[m] * (1.f / 2048.f) + EPS);
#pragma unroll
                for (int j = 0; j < 8; ++j) { const f32x4 yv = __builtin_nontemporal_load(&orow[64 * j]), xv = __builtin_nontemporal_load(&xr[64 * j]), gv = gr[64 * j]; __builtin_nontemporal_store(xv + yv * rinv * gv, &orow[64 * j]); }
            }
        }
        if (ph + 1 < a.ph_hi) { if (ph == 0) cg::this_grid().sync(); else { XcdBarrier bar; bar.bar = (unsigned*)(a.ws + WS_BAR); bar.x = xb_xcc_id(); bar.st = (volatile LAS unsigned*)(lds + (LDS_BYTES - 64)); xcd_barrier(bar); } }
    }
}


#ifndef DBG
#define DBG 0
#endif
#if DBG
constexpr size_t WS_CHK = 600000;
struct DArgs { const float* in[15]; float* out; unsigned char* ws; int stage, pad; };
__device__ __forceinline__ float bf2f(bf16_t v) { return __builtin_bit_cast(float, (unsigned)v << 16); }
__device__ __forceinline__ void chk_update(unsigned* slot, float got, float ref) { float* f = (float*)slot; float d = got - ref; if (!(d == d)) d = 1e6f; atomicAdd(f, d * d); atomicAdd(f + 16, ref * ref); }
__device__ __forceinline__ const float* xrow_of(const DArgs& a, int row) { return row < NPROMPT ? a.in[0] + (size_t)row * 2048 : a.in[1] + (size_t)(row - NPROMPT) * 2048; }
__global__ void dbg_check(DArgs a) {
    const int gid = blockIdx.x * blockDim.x + threadIdx.x, NT = gridDim.x * blockDim.x;
    unsigned char* ws = a.ws; unsigned* chk = (unsigned*)(ws + WS_CHK);
    const bf16_t* H = (const bf16_t*)(ws + WS_H); const bf16_t* P = (const bf16_t*)(ws + WS_P); const bf16_t* KR = (const bf16_t*)(ws + WS_KR);
    const bf16_t* MEMN = (const bf16_t*)(ws + WS_MEMN); const bf16_t* MKV = (const bf16_t*)(ws + WS_MKV);
    const bf16_t* QB = (const bf16_t*)(ws + WS_QB); const bf16_t* KVB = (const bf16_t*)(ws + WS_KVB); const bf16_t* Y = H;
    const float* ssq_y = (const float*)(ws + WS_SSQ_Y);
    if (a.stage == 1) {
        for (int s = gid; s < 1024; s += NT) {
            const int row = (int)(((unsigned)s * 7919u + 13u) % NTOK), k = (s * 131 + 7) % 2048; const float* xr = xrow_of(a, row);
            float q = 0.f; for (int i = 0; i < 2048; ++i) q += xr[i] * xr[i];
            chk_update(chk + 0, bf2f(H[(size_t)row * 2048 + k]), xr[k] * rsqrtf(q / 2048.f + EPS) * a.in[4][k]);
        }
        for (int s = gid; s < 2048; s += NT) {
            const int row = (int)(((unsigned)s * 7919u + 101u) % NTOK), n = (int)(((unsigned)s * 40503u + 17u) % 6144);
            const int src = n < 4096 ? n : n + 64; const float cs = (n < 1536 || (n >= PC_CQ && n < PC_CG)) ? QS128 : 1.f;
            float acc = 0.f; for (int k = 0; k < 2048; ++k) acc += bf2f(H[(size_t)row * 2048 + k]) * a.in[5][(size_t)k * 6208 + src];
            chk_update(chk + 0, bf2f(P[(size_t)row * NP + n]), acc * cs);
        }
        for (int s = gid; s < 1024; s += NT) {
            const int row = (int)(((unsigned)s * 7919u + 5u) % NTOK), j = s & 63, i = j >> 1;
            float x1 = 0.f, x2 = 0.f; for (int k = 0; k < 2048; ++k) { const float h = bf2f(H[(size_t)row * 2048 + k]); x1 += h * a.in[5][(size_t)k * 6208 + 4096 + i]; x2 += h * a.in[5][(size_t)k * 6208 + 4096 + i + 32]; }
            const float ang = (float)row_pos(row) * exp2f(-(float)i * (13.287712379549449f / 32.f)); const float c = cosf(ang), sn = sinf(ang);
            chk_update(chk + 1, bf2f(KR[(size_t)row * 64 + j]), (j & 1) ? x1 * sn + x2 * c : x1 * c - x2 * sn);
        }
        for (int s = gid; s < 1024; s += NT) {
            const int row = (s * 37 + 3) % 1536, n = (s * 61 + 11) % 1024;
            float acc = 0.f; for (int k = 0; k < 2048; ++k) acc += bf2f(MEMN[(size_t)row * 2048 + k]) * a.in[11][(size_t)k * 1024 + n];
            chk_update(chk + 4, bf2f(MKV[(size_t)row * 1024 + n]), acc);
        }
    } else if (a.stage == 2) {
        for (int s = gid; s < 2048; s += NT) {
            const int row = (int)(((unsigned)s * 7919u + 29u) % NTOK), n = (int)(((unsigned)s * 40503u + 3u) % 1536); const int hd = n / 192, cm = n % 192;
            float q = 0.f; for (int k = 0; k < 512; ++k) { const float v = bf2f(P[(size_t)row * NP + PC_BCQ + k]); q += v * v; }
            const float rinv = rsqrtf(q / 512.f + EPS);
            float ref;
            if (cm < 128) { float acc = 0.f; for (int k = 0; k < 512; ++k) acc += bf2f(P[(size_t)row * NP + PC_BCQ + k]) * a.in[6][k] * a.in[7][(size_t)k * 1536 + n]; ref = acc * rinv * QS192; }
            else { const int j = cm - 128, i = j >> 1; float x1 = 0.f, x2 = 0.f;
                for (int k = 0; k < 512; ++k) { const float v = bf2f(P[(size_t)row * NP + PC_BCQ + k]) * a.in[6][k]; x1 += v * a.in[7][(size_t)k * 1536 + hd * 192 + 128 + i]; x2 += v * a.in[7][(size_t)k * 1536 + hd * 192 + 128 + i + 32]; }
                x1 *= rinv * QS192; x2 *= rinv * QS192;
                const float ang = (float)row_pos(row) * exp2f(-(float)i * (13.287712379549449f / 32.f)); const float c = cosf(ang), sn = sinf(ang);
                ref = (j & 1) ? x1 * sn + x2 * c : x1 * c - x2 * sn; }
            chk_update(chk + 2, bf2f(QB[(size_t)row * 1536 + n]), ref);
        }
        for (int s = gid; s < 2048; s += NT) {
            const int row = (int)(((unsigned)s * 7919u + 31u) % NTOK), n = (int)(((unsigned)s * 40503u + 9u) % 2048);
            float q = 0.f, acc = 0.f; for (int k = 0; k < 512; ++k) { const float v = bf2f(P[(size_t)row * NP + PC_BCKV + k]); q += v * v; acc += v * a.in[8][k] * a.in[9][(size_t)k * 2048 + n]; }
            chk_update(chk + 3, bf2f(KVB[(size_t)row * 2048 + n]), acc * rsqrtf(q / 512.f + EPS));
        }
    } else if (a.stage == 3) {
        const float LN2 = 0.6931471805599453f;
        for (int s = gid; s < 512; s += NT) {
            const int row = (int)(((unsigned)s * 7919u + 77u) % NTOK), head = s & 3, d = (s * 29 + 5) & 127;
            int seq0, S; if (row < NPROMPT) { S = 8192; seq0 = row & ~8191; } else { S = 4096; seq0 = NPROMPT + ((row - NPROMPT) & ~4095); }
            const int t = row - seq0; float og[3], lse[3];
            for (int g = 0; g < 3; ++g) { const int dil = g == 0 ? 1 : (g == 1 ? 4 : 16); float m = -1e30f, den = 0.f, o = 0.f;
                for (int pass = 0; pass < 2; ++pass) for (int j = -64; j <= 64; ++j) { const int tk = t + j * dil; if (tk < 0 || tk >= S) continue;
                    float dot = 0.f; for (int e = 0; e < 128; ++e) dot += bf2f(P[(size_t)row * NP + PC_AQ + g * 512 + head * 128 + e]) * bf2f(P[(size_t)(seq0 + tk) * NP + PC_AK + head * 128 + e]);
                    const float sc = dot * LN2 + a.in[14][t5_bucket(j * dil) * 12 + g * 4 + head];
                    if (pass == 0) m = fmaxf(m, sc); else { const float p = expf(sc - m); den += p; o += p * bf2f(P[(size_t)(seq0 + tk) * NP + PC_AV + head * 128 + d]); } }
                og[g] = o / den; lse[g] = m + logf(den); }
            const float ml = fmaxf(lse[0], fmaxf(lse[1], lse[2])); const float e0 = expf(lse[0] - ml), e1 = expf(lse[1] - ml), e2 = expf(lse[2] - ml);
            const float oa = (e0 * og[0] + e1 * og[1] + e2 * og[2]) / (e0 + e1 + e2); const float gt = bf2f(P[(size_t)row * NP + PC_AG + head * 128 + d]);
            chk_update(chk + 5, bf2f(Y[(size_t)row * 2048 + head * 128 + d]), oa * gt / (1.f + expf(-gt)));
        }
        for (int s = gid; s < 256; s += NT) {
            const int row = (int)(((unsigned)s * 7919u + 55u) % NTOK), head = s & 7, d = (s * 29 + 5) & 127;
            int seq0, S; if (row < NPROMPT) { S = 8192; seq0 = row & ~8191; } else { S = 4096; seq0 = NPROMPT + ((row - NPROMPT) & ~4095); }
            float m = -1e30f, den = 0.f, o = 0.f;
            for (int tk = 0; tk < S; ++tk) { float dot = 0.f;
                for (int e = 0; e < 128; ++e) dot += bf2f(QB[(size_t)row * 1536 + head * 192 + e]) * bf2f(KVB[(size_t)(seq0 + tk) * 2048 + head * 256 + e]);
                for (int e = 0; e < 64; ++e) dot += bf2f(QB[(size_t)row * 1536 + head * 192 + 128 + e]) * bf2f(KR[(size_t)(seq0 + tk) * 64 + e]);
                const float sc = dot * LN2; const float mn = fmaxf(m, sc); const float al = expf(m - mn), p = expf(sc - mn);
                den = den * al + p; o = o * al + p * bf2f(KVB[(size_t)(seq0 + tk) * 2048 + head * 256 + 128 + d]); m = mn; }
            const float gt = bf2f(P[(size_t)row * NP + PC_BG + head * 128 + d]);
            chk_update(chk + 6, bf2f(Y[(size_t)row * 2048 + 512 + head * 128 + d]), o / den * gt / (1.f + expf(-gt)));
        }
        for (int s = gid; s < 512; s += NT) {
            const int row = (int)(((unsigned)s * 7919u + 91u) % NTOK), head = s & 3, d = (s * 29 + 5) & 127;
            const int mb = row < NPROMPT ? (row >> 13) : 4 + ((row - NPROMPT) >> 12);
            float m = -1e30f, den = 0.f, o = 0.f;
            for (int tk = 0; tk < 256; ++tk) { float dot = 0.f;
                for (int e = 0; e < 128; ++e) dot += bf2f(P[(size_t)row * NP + PC_CQ + head * 128 + e]) * bf2f(MKV[(size_t)(mb * 256 + tk) * 1024 + head * 128 + e]);
                const float sc = dot * LN2; const float mn = fmaxf(m, sc); const float al = expf(m - mn), p = expf(sc - mn);
                den = den * al + p; o = o * al + p * bf2f(MKV[(size_t)(mb * 256 + tk) * 1024 + 512 + head * 128 + d]); m = mn; }
            const float gt = bf2f(P[(size_t)row * NP + PC_CG + head * 128 + d]);
            { const float got_ = bf2f(Y[(size_t)row * 2048 + 1536 + head * 128 + d]), ref_ = o / den * gt / (1.f + expf(-gt));
              chk_update(chk + 7, got_, ref_); chk_update(chk + ((row & 31) < 16 ? 9 : 10), got_, ref_); chk_update(chk + (d < 64 ? 11 : 12), got_, ref_); }
        }
    } else if (a.stage == 4) {
        for (int s = gid; s < 1024; s += NT) {
            const int row = (int)(((unsigned)s * 7919u + 41u) % NTOK), n = (int)(((unsigned)s * 40503u + 1u) % 2048);
            float acc = 0.f; for (int k = 0; k < 2048; ++k) acc += bf2f(Y[(size_t)row * 2048 + k]) * a.in[12][(size_t)k * 2048 + n];
            chk_update(chk + 8, a.out[(size_t)row * 2048 + n], acc);
        }
        for (int s = gid; s < 256; s += NT) {
            const int row = (int)(((unsigned)s * 7919u + 43u) % NTOK); float q = 0.f; for (int k = 0; k < 2048; ++k) { const float v = a.out[(size_t)row * 2048 + k]; q += v * v; }
            chk_update(chk + 8, ssq_y[row], q);
        }
    }
}
__global__ void dbg_encode(DArgs a) {
    const float* chf = (const float*)(a.ws + WS_CHK); unsigned chk[9];
    for (int i = 0; i < 9; ++i) chk[i] = (chf[i] > 4e-4f * chf[16 + i] || !(chf[16 + i] > 0.f)) ? 1u : 0u;
    const int code4 = (chk[0] ? 1 : 0) | (chk[1] ? 2 : 0) | (chk[2] ? 4 : 0) | (chk[3] ? 8 : 0);
    const int code5 = (chk[4] ? 1 : 0) | (chk[5] ? 2 : 0) | (chk[6] ? 4 : 0) | (chk[7] ? 8 : 0) | (chk[8] ? 16 : 0);
    const size_t gid = (size_t)blockIdx.x * blockDim.x + threadIdx.x, NT = (size_t)gridDim.x * blockDim.x;
    for (size_t e = gid; e < (size_t)NTOK * 2048; e += NT) { const int row = (int)(e >> 11); const float xv = xrow_of(a, row)[e & 2047];
        float v = ((row & 15) < code4) ? 0.f : xv; if (e == 0 && code5) v = 100.f + 20.f * code5; a.out[e] = v; }
}
#endif

extern "C" void kernel_launch(void* const* d_in, const int* in_sizes, int n_in, void* d_out, int out_size, void* d_ws, size_t ws_size, hipStream_t stream) {
    static int grid = 0;
    if (grid == 0) {
        if (n_in != 15 || out_size != NTOK * DMODEL || ws_size < WS_END) { fprintf(stderr, "kernel_launch: unexpected shapes n_in %d out %d ws %zu\n", n_in, out_size, ws_size); grid = -1; return; }
        int dev = 0, cus = 0, per_cu = 0;
        hipGetDevice(&dev); hipDeviceGetAttribute(&cus, hipDeviceAttributeMultiprocessorCount, dev);
        if (hipFuncSetAttribute((const void*)mega_fwd, hipFuncAttributeMaxDynamicSharedMemorySize, LDS_BYTES) != hipSuccess) { fprintf(stderr, "kernel_launch: hipFuncSetAttribute failed\n"); grid = -1; return; }
        if (hipOccupancyMaxActiveBlocksPerMultiprocessor(&per_cu, (const void*)mega_fwd, 512, LDS_BYTES) != hipSuccess || per_cu < 1) { fprintf(stderr, "kernel_launch: occupancy query gave %d\n", per_cu); per_cu = 1; }
        (void)hipGetLastError();
        grid = cus * per_cu;
    }
    if (grid < 0) return;
    Args a{};
    for (int i = 0; i < 15; ++i) a.in[i] = (const float*)d_in[i];
    a.out = (float*)d_out; a.ws = (unsigned char*)d_ws;
#if MK_SINGLE
    (void)hipMemsetAsync((char*)d_ws + WS_BAR, 0, XCD_BAR_WORDS * 4, stream);
    a.ph_lo = 0; a.ph_hi = 7;
    void* args[] = {&a};
    hipError_t e = hipLaunchCooperativeKernel((const void*)mega_fwd, dim3(grid), dim3(512), args, LDS_BYTES, stream);
    if (e != hipSuccess) fprintf(stderr, "cooperative launch failed: %s (grid %d)\n", hipGetErrorString(e), grid);
#else
#if DBG
    DArgs da{}; for (int i = 0; i < 15; ++i) da.in[i] = (const float*)d_in[i]; da.out = (float*)d_out; da.ws = (unsigned char*)d_ws;
    (void)hipMemsetAsync((char*)d_ws + WS_CHK, 0, 128, stream);
#endif
    for (int ph = 0; ph < 7; ++ph) {
        a.ph_lo = ph; a.ph_hi = ph + 1;
        hipLaunchKernelGGL(mega_fwd, dim3(grid), dim3(512), LDS_BYTES, stream, a);
#if DBG
        if (ph >= 1 && ph <= 4) { da.stage = ph; hipLaunchKernelGGL(dbg_check, dim3(256), dim3(64), 0, stream, da); }
#endif
    }
#if DBG
    hipLaunchKernelGGL(dbg_encode, dim3(2048), dim3(256), 0, stream, da);
#endif
#endif
}
```
